# Optimizing an MI355X kernel written in HIP

```python
import jax, jax.numpy as jnp
from jax import lax
import numpy as np

D_MODEL = 1024
BATCH = 32
SEQ = 256
DEPTH = 2
DEC_BATCH = 4
DEC_SEQ = 2048
PAST_LEN = 256

GRID_W = 64
D_MIX = D_MODEL
HEAD_A = 64
D_A = D_MIX // 2
H_A = D_A // HEAD_A
D_B = D_MIX // 4
H_B = 4
BLK_B = D_B // H_B
D_C = D_MIX - D_A - D_B
HEAD_C = 64
H_C = D_C // HEAD_C
LORA_W = 64
LORA_A = 64
LORA_G = 128
CONV_B = 4
CONV_F = 3
RG_C = 8.0
CHUNK_C = 64
D_FF = ((8 * D_MODEL // 3 + 255) // 256) * 256
N_DIR = 2
N_MOD = 6
RMS_EPS = 1e-6
GN_EPS = 64e-5
SPLIT_SIZES = (D_A, D_A, D_A, LORA_W, LORA_W, LORA_A, LORA_A, LORA_G,
               D_B, D_B,
               D_C, D_C, D_C, D_C, D_C)
IN_COLS = sum(SPLIT_SIZES)

kernel_name = 'hybrid_prefix_diffusion_step'


def rms_norm(x, g):
    xf = x.astype(jnp.float32)
    y = xf * lax.rsqrt(jnp.mean(xf * xf, axis=-1, keepdims=True) + RMS_EPS)
    return (y * g.astype(jnp.float32)).astype(x.dtype)


def dwconv(x, w, b, pad):
    y = lax.conv_general_dilated(x, w[:, None, :].astype(x.dtype), window_strides=(1,), padding=[pad],
                                 dimension_numbers=('NWC', 'WIO', 'NWC'), feature_group_count=x.shape[-1])
    return y + b.astype(x.dtype)


def modulation(cond, ada_w, ada_b):
    m = jax.nn.silu(cond) @ ada_w + ada_b
    return jnp.split(m[:, None, :], N_MOD, axis=-1)


def rwkv7_recurrence(r, w, k, v, kk, a, s0, reverse):
    def step(S, inp):
        r_t, w_t, k_t, v_t, kk_t, a_t = inp
        s_kk = jnp.einsum('bhvk,bhk->bhv', S, kk_t)
        S = (S * w_t[:, :, None, :] - s_kk[..., None] * (kk_t * a_t)[:, :, None, :]
             + v_t[..., None] * k_t[:, :, None, :])
        return S, jnp.einsum('bhvk,bhk->bhv', S, r_t)
    xs = tuple(jnp.moveaxis(t, 1, 0) for t in (r, w, k, v, kk, a))
    s_fin, o = lax.scan(step, s0, xs, reverse=reverse)
    return jnp.moveaxis(o, 0, 1), s_fin


def rwkv7_mixer(r, k, v, wd, ad, gd, s0, p):
    Bn, T, _ = r.shape
    heads = lambda t: t.reshape(Bn, T, H_A, HEAD_A)
    kk = heads(k * p['rwkv_k_k'])
    kk = kk * lax.rsqrt(jnp.sum(kk * kk, axis=-1, keepdims=True) + 1e-12)
    rh, vh = heads(r), heads(v)
    outs, finals = [], []
    for d in range(N_DIR):
        wl = p['rwkv_w0'][d] + jnp.tanh(wd[d]) @ p['rwkv_w_up'][d]
        decay = jnp.exp(-jnp.exp(-jax.nn.softplus(-wl) - 0.5))
        a = jax.nn.sigmoid(p['rwkv_a0'][d] + ad[d] @ p['rwkv_a_up'][d])
        kd = k * (1.0 + (a - 1.0) * p['rwkv_k_a'])
        od, sd = rwkv7_recurrence(rh, heads(decay), heads(kd), vh, kk, heads(a), s0[:, d], reverse=(d == 1))
        outs.append(od)
        finals.append(sd)
    o = outs[0] + outs[1]
    mu = jnp.mean(o, axis=-1, keepdims=True)
    var = jnp.mean(jnp.square(o - mu), axis=-1, keepdims=True)
    o = ((o - mu) * lax.rsqrt(var + GN_EPS)).reshape(Bn, T, D_A) * p['rwkv_ln_w'] + p['rwkv_ln_b']
    bonus = jnp.sum(rh * heads(k) * p['rwkv_r_k'], axis=-1, keepdims=True) * vh
    o = (o + bonus.reshape(Bn, T, D_A)) * (jax.nn.sigmoid(gd) @ p['rwkv_g_up'])
    return o, jnp.stack(finals, axis=1)


def diag_linear_scan(a, b, h0, reverse):
    def combine(e, l):
        return (e[0] * l[0], l[0] * e[1] + l[1])
    a_cum, b_cum = lax.associative_scan(combine, (a, b), axis=1, reverse=reverse)
    h = a_cum * h0[:, None, :] + b_cum
    return h, (h[:, 0] if reverse else h[:, -1])


def rglru_mixer(xb, gb, h0, p):
    Bn, T, _ = xb.shape
    u = dwconv(xb, p['lru_conv_w'], p['lru_conv_b'], (CONV_B // 2, CONV_B - 1 - CONV_B // 2))
    ub = u.reshape(Bn, T, H_B, BLK_B)
    hs, finals = [], []
    for d in range(N_DIR):
        rg = jax.nn.sigmoid(jnp.einsum('bthi,hij->bthj', ub, p['lru_wa'][d]).reshape(Bn, T, D_B) + p['lru_ba'][d])
        ig = jax.nn.sigmoid(jnp.einsum('bthi,hij->bthj', ub, p['lru_wx'][d]).reshape(Bn, T, D_B) + p['lru_bx'][d])
        log_a = -RG_C * rg * jax.nn.softplus(-p['lru_lambda'][d])
        h, h_fin = diag_linear_scan(jnp.exp(log_a), jnp.sqrt(-jnp.expm1(2.0 * log_a)) * (ig * u),
                                    h0[:, d], reverse=(d == 1))
        hs.append(h)
        finals.append(h_fin)
    y = (hs[0] + hs[1]) * jax.nn.gelu(gb)
    return y, jnp.stack(finals, axis=1)


def hgrn2_chunk_scan(q, log_f, k, v, s0):
    Bn, T, H, _ = q.shape
    n_chunks = T // CHUNK_C
    chunks = lambda t: jnp.moveaxis(t.reshape(Bn, n_chunks, CHUNK_C, H, t.shape[-1]), 1, 0)
    causal = jnp.tril(jnp.ones((CHUNK_C, CHUNK_C), dtype=bool))[None, :, :, None, None]

    def step(S, inp):
        qc, lfc, kc, vc = inp
        b = jnp.cumsum(lfc, axis=1)
        o_inter = jnp.einsum('blhk,bhkv->blhv', qc * jnp.exp(b), S)
        rel = jnp.exp(jnp.where(causal, b[:, :, None] - b[:, None, :], -jnp.inf))
        att = jnp.einsum('bthk,bshk,btshk->bhts', qc, kc, rel)
        o_intra = jnp.einsum('bhts,bshv->bthv', att, vc)
        b_last = b[:, -1]
        S = (jnp.exp(b_last)[..., None] * S
             + jnp.einsum('bshk,bshv->bhkv', kc * jnp.exp(b_last[:, None] - b), vc))
        return S, o_inter + o_intra

    s_fin, o = lax.scan(step, s0, tuple(chunks(t) for t in (q, log_f, k, v)))
    return jnp.moveaxis(o, 0, 1).reshape(Bn, T, H, v.shape[-1]), s_fin


def hgrn2_mixer(q, f_raw, iv, og, s0, p):
    Bn, T, _ = q.shape
    heads = lambda t: t.reshape(Bn, T, H_C, HEAD_C)
    qh, vh = heads(jax.nn.silu(q)), heads(iv)
    lb = p['hgrn_lb']
    outs, finals = [], []
    for d in range(N_DIR):
        f = lb[d] + (1.0 - lb[d]) * jax.nn.sigmoid(f_raw[d])
        args = (qh, heads(jnp.log(f)), heads(1.0 - f), vh)
        if d == 1:
            args = tuple(jnp.flip(t, axis=1) for t in args)
        od, sd = hgrn2_chunk_scan(*args, s0[:, d])
        outs.append(jnp.flip(od, axis=1) if d == 1 else od)
        finals.append(sd)
    o = outs[0] + outs[1]
    o = o * lax.rsqrt(jnp.mean(o * o, axis=-1, keepdims=True) + RMS_EPS)
    o = o.reshape(Bn, T, D_C) * p['hgrn_norm_g'] * jax.nn.silu(og)
    return o, jnp.stack(finals, axis=1)


def conv_ffn(h, p, on_grid):
    g = h @ p['ffn_w_gate']
    Bn, T, F = g.shape
    if on_grid:
        rows = T // GRID_W
        g = dwconv(g.reshape(Bn * rows, GRID_W, F), p['ffn_conv_w'], p['ffn_conv_b'], (1, 1)).reshape(Bn, T, F)
    else:
        g = dwconv(g, p['ffn_conv_w'], p['ffn_conv_b'], (1, 1))
    return (jax.nn.silu(g) * (h @ p['ffn_w_up'])) @ p['ffn_w_down']


def trunk_layer(x, mods, s_rwkv, s_lru, s_hgrn, p, on_grid):
    shift1, scale1, gate1, shift2, scale2, gate2 = mods
    h = rms_norm(x, p['norm_mix_g']) * (1.0 + scale1) + shift1
    idx = np.cumsum(SPLIT_SIZES)[:-1].tolist()
    (r, k, v, wd_f, wd_b, ad_f, ad_b, gd, xb, gb, q, ff, fb, iv, og) = jnp.split(
        (h @ p['w_in']).astype(jnp.float32), idx, axis=-1)
    o_a, s_a = rwkv7_mixer(r, k, v, (wd_f, wd_b), (ad_f, ad_b), gd, s_rwkv, p)
    o_b, s_b = rglru_mixer(xb, gb, s_lru, p)
    o_c, s_c = hgrn2_mixer(q, (ff, fb), iv, og, s_hgrn, p)
    mix = jnp.concatenate([o_a, o_b, o_c], axis=-1).astype(x.dtype) @ p['w_out']
    x = x + gate1 * mix
    h = rms_norm(x, p['norm_ffn_g']) * (1.0 + scale2) + shift2
    x = x + gate2 * conv_ffn(h, p, on_grid)
    return x, s_a, s_b, s_c


def setup_inputs(seed: int = 0) -> dict:
    key = jax.random.key(seed)
    ks = iter(jax.random.split(key, 64))
    nrm = lambda shape, scale: scale * jax.random.normal(next(ks), shape, jnp.float32)
    unif = lambda shape, lo, hi: jax.random.uniform(next(ks), shape, jnp.float32, lo, hi)
    L, D = DEPTH, D_MODEL
    return {
        'x_prompt': nrm((BATCH, SEQ, D), 1.0),
        'x_sample': nrm((DEC_BATCH, DEC_SEQ, D), 1.0),
        'state_rwkv': nrm((DEC_BATCH, DEPTH, N_DIR, H_A, HEAD_A, HEAD_A), 0.5),
        'state_rglru': nrm((DEC_BATCH, DEPTH, N_DIR, D_B), 0.5),
        'state_hgrn': nrm((DEC_BATCH, DEPTH, N_DIR, H_C, HEAD_C, HEAD_C), 0.5),
        'c': nrm((DEC_BATCH, D), 1.0),
        'c_ctx': nrm((D,), 1.0),
        'ada_w': nrm((L, D, N_MOD * D), 0.5 * D ** -0.5),
        'ada_b': nrm((L, N_MOD * D), 0.02),
        'norm_mix_g': 1.0 + nrm((L, D), 0.05),
        'norm_ffn_g': 1.0 + nrm((L, D), 0.05),
        'w_in': nrm((L, D, IN_COLS), D ** -0.5),
        'w_out': nrm((L, D_MIX, D), D_MIX ** -0.5),
        'rwkv_w0': unif((L, N_DIR, D_A), -6.0, 0.0),
        'rwkv_w_up': nrm((L, N_DIR, LORA_W, D_A), 0.1 * LORA_W ** -0.5),
        'rwkv_a0': nrm((L, N_DIR, D_A), 0.1),
        'rwkv_a_up': nrm((L, N_DIR, LORA_A, D_A), 0.1 * LORA_A ** -0.5),
        'rwkv_g_up': nrm((L, LORA_G, D_A), LORA_G ** -0.5),
        'rwkv_k_k': 0.85 + nrm((L, D_A), 0.05),
        'rwkv_k_a': 1.0 + nrm((L, D_A), 0.05),
        'rwkv_r_k': nrm((L, H_A, HEAD_A), 0.1),
        'rwkv_ln_w': 1.0 + nrm((L, D_A), 0.05),
        'rwkv_ln_b': nrm((L, D_A), 0.02),
        'lru_conv_w': nrm((L, CONV_B, D_B), CONV_B ** -0.5),
        'lru_conv_b': nrm((L, D_B), 0.02),
        'lru_wa': nrm((L, N_DIR, H_B, BLK_B, BLK_B), BLK_B ** -0.5),
        'lru_ba': nrm((L, N_DIR, D_B), 0.02),
        'lru_wx': nrm((L, N_DIR, H_B, BLK_B, BLK_B), BLK_B ** -0.5),
        'lru_bx': nrm((L, N_DIR, D_B), 0.02),
        'lru_lambda': unif((L, N_DIR, D_B), 4.3, 9.0),
        'hgrn_lb_logits': nrm((N_DIR, L, D_C), 1.0),
        'hgrn_norm_g': 1.0 + nrm((L, D_C), 0.05),
        'ffn_w_gate': nrm((L, D, D_FF), D ** -0.5),
        'ffn_w_up': nrm((L, D, D_FF), D ** -0.5),
        'ffn_conv_w': nrm((L, CONV_F, D_FF), CONV_F ** -0.5),
        'ffn_conv_b': nrm((L, D_FF), 0.02),
        'ffn_w_down': nrm((L, D_FF, D), D_FF ** -0.5),
        'final_g': 1.0 + nrm((D,), 0.05),
    }


def reference(x_prompt, x_sample, state_rwkv, state_rglru, state_hgrn, c, c_ctx, ada_w, ada_b,
              norm_mix_g, norm_ffn_g, w_in, w_out, rwkv_w0, rwkv_w_up, rwkv_a0, rwkv_a_up, rwkv_g_up,
              rwkv_k_k, rwkv_k_a, rwkv_r_k, rwkv_ln_w, rwkv_ln_b, lru_conv_w, lru_conv_b, lru_wa, lru_ba,
              lru_wx, lru_bx, lru_lambda, hgrn_lb_logits, hgrn_norm_g, ffn_w_gate, ffn_w_up, ffn_conv_w,
              ffn_conv_b, ffn_w_down, final_g):
    f32 = jnp.float32
    lb_all = jnp.cumsum(jax.nn.softmax(hgrn_lb_logits.astype(f32), axis=1), axis=1)
    lb_all = lb_all - lb_all[:, :1]
    n_ctx = x_prompt.shape[0]
    z_rwkv = jnp.zeros((n_ctx, N_DIR, H_A, HEAD_A, HEAD_A), f32)
    z_lru = jnp.zeros((n_ctx, N_DIR, D_B), f32)
    z_hgrn = jnp.zeros((n_ctx, N_DIR, H_C, HEAD_C, HEAD_C), f32)
    xp, xs = x_prompt, x_sample
    new_rwkv, new_lru, new_hgrn = [], [], []
    for l in range(DEPTH):
        p = {
            'norm_mix_g': norm_mix_g[l], 'norm_ffn_g': norm_ffn_g[l], 'w_in': w_in[l], 'w_out': w_out[l],
            'rwkv_w0': rwkv_w0[l], 'rwkv_w_up': rwkv_w_up[l], 'rwkv_a0': rwkv_a0[l], 'rwkv_a_up': rwkv_a_up[l],
            'rwkv_g_up': rwkv_g_up[l], 'rwkv_k_k': rwkv_k_k[l], 'rwkv_k_a': rwkv_k_a[l], 'rwkv_r_k': rwkv_r_k[l],
            'rwkv_ln_w': rwkv_ln_w[l], 'rwkv_ln_b': rwkv_ln_b[l],
            'lru_conv_w': lru_conv_w[l], 'lru_conv_b': lru_conv_b[l], 'lru_wa': lru_wa[l], 'lru_ba': lru_ba[l],
            'lru_wx': lru_wx[l], 'lru_bx': lru_bx[l], 'lru_lambda': lru_lambda[l],
            'hgrn_lb': lb_all[:, l], 'hgrn_norm_g': hgrn_norm_g[l],
            'ffn_w_gate': ffn_w_gate[l], 'ffn_w_up': ffn_w_up[l], 'ffn_conv_w': ffn_conv_w[l],
            'ffn_conv_b': ffn_conv_b[l], 'ffn_w_down': ffn_w_down[l],
        }
        xp, s_a, s_b, s_c = trunk_layer(xp, modulation(c_ctx[None, :], ada_w[l], ada_b[l]),
                                        z_rwkv, z_lru, z_hgrn, p, on_grid=False)
        new_rwkv.append(s_a)
        new_lru.append(s_b)
        new_hgrn.append(s_c)
        xs, _, _, _ = trunk_layer(xs, modulation(c, ada_w[l], ada_b[l]),
                                  state_rwkv[:, l].astype(f32), state_rglru[:, l].astype(f32),
                                  state_hgrn[:, l].astype(f32), p, on_grid=True)
    y_prompt = rms_norm(xp, final_g)
    y_sample = rms_norm(xs, final_g)
    new_rwkv_state = jnp.stack(new_rwkv, axis=1).astype(x_prompt.dtype)
    new_rglru_state = jnp.stack(new_lru, axis=1).astype(x_prompt.dtype)
    new_hgrn_state = jnp.stack(new_hgrn, axis=1).astype(x_prompt.dtype)
    return (y_prompt, y_sample, new_rwkv_state, new_rglru_state, new_hgrn_state)
```

```cpp
#include <hip/hip_runtime.h>
#include <cstdio>
#include <cstdint>
namespace pg8 {
#define PG8_LAS __attribute__((address_space(3)))
typedef unsigned short bf16_t;
typedef short bf16x8 __attribute__((ext_vector_type(8)));
typedef float f32x4 __attribute__((ext_vector_type(4)));
typedef unsigned u32x4 __attribute__((ext_vector_type(4)));
constexpr int BM = 256, BK = 64, HALF = 128, HTB = HALF * BK * 2  , STAGE_BYTES = 8 * HTB, NXCD = 8, WGM = 8;

__host__ __device__ __forceinline__ int lds_byte(int r, int c) { const int st = (r >> 4) * 2 + (c >> 5), rr = r & 15, cc = c & 31, ob = rr * 64 + cc * 2; return st * 1024 + (ob ^ (((ob >> 9) & 1) << 5)); }
__host__ __device__ __forceinline__ void stage_rc(int b, int& R, int& C) { const int st = b / 1024, sb = b % 1024, swz = sb ^ (((sb >> 9) & 1) << 5); R = (st >> 1) * 16 + swz / 64; C = (st & 1) * 32 + (swz % 64) / 2; }
__host__ __device__ __forceinline__ int perm32(int rho) { const int n = rho >> 4, i = rho & 15; return 8 * (i >> 2) + 4 * n + (i & 3); }

struct Unit { int pm, pn; };
struct Gemm { const bf16_t* A; const bf16_t* Bt; int M, N, K, lda, rowperm; };

struct StaticOrder {
    int nM, nN, nwg, G, c;
    __host__ __device__ void init(int M, int N, int G_, int c_) { nM = M / BM; nN = N / BM; nwg = nM * nN; G = G_; c = c_; }
    __host__ __device__ bool next(int i, Unit& u) const {
        const long L = (long)i * G + c; if (L >= nwg) return false;
        int wgid = (int)L; { const int q = nwg / NXCD, r = nwg % NXCD, xcd = wgid % NXCD, off = wgid / NXCD; wgid = (xcd < r ? xcd * (q + 1) : r * (q + 1) + (xcd - r) * q) + off; }
        const int nig = WGM * nN, gid = wgid / nig, fm = gid * WGM, gsz = (nM - fm) < WGM ? (nM - fm) : WGM;
        u.pm = fm + ((wgid % nig) % gsz); u.pn = (wgid % nig) / gsz; return true;
    }
    __device__ __forceinline__ void a_ready(const Unit&) const {}
    __device__ __forceinline__ void done(const Unit&) const {}
};

__device__ __forceinline__ unsigned cvt_pk_bf16(float lo, float hi) { unsigned r; asm volatile("v_cvt_pk_bf16_f32 %0, %1, %2" : "=v"(r) : "v"(lo), "v"(hi)); return r; }
__device__ __forceinline__ float fsigmoid(float x) { return __builtin_amdgcn_rcpf(1.0f + __expf(-x)); }
__device__ __forceinline__ float ftanh(float x) { return 1.0f - 2.0f * __builtin_amdgcn_rcpf(1.0f + __expf(2.0f * x)); }
__device__ __forceinline__ float bf_lo(unsigned w) { return __uint_as_float(w << 16); }
__device__ __forceinline__ float bf_hi(unsigned w) { return __uint_as_float(w & 0xffff0000u); }

constexpr int PP = 3712;
enum EpiKind { K_PROJ = 0, K_LORA = 1, K_PLAIN = 2, K_GATES = 3, K_RESID = 4, K_GUACT = 5 };
constexpr int XCH_OFF = 131072 + 8192;
struct EpiAny {
    static constexpr bool AFTER_DRAIN = false;
    int kind, ldc; bf16_t* O; const float* f0; const float* f1; const float* f2; const bf16_t* U; float* xout;
    __device__ __forceinline__ bool perm() const { return kind != K_RESID; }
    __device__ __forceinline__ void operator()(const f32x4 (&acc)[2][2][4][2], const Unit& u, int wr, int wc, int fr, int fq, PG8_LAS unsigned char* lds) const {
        const int row0 = u.pm * BM + wr * 64 + fr;
        if (kind == K_GUACT) {
            const bool ctx = u.pm < 32;
            const int cb0 = u.pn * HALF + wc * 32 + 8 * fq;
            PG8_LAS float* xch = (PG8_LAS float*)(lds + XCH_OFF);
            if (fr == (wr == 0 ? 15 : 0)) {
#pragma unroll
                for (int n = 0; n < 2; ++n)
#pragma unroll
                    for (int j = 0; j < 4; ++j) xch[((wr * 4 + wc) * 4 + fq) * 8 + 4 * n + j] = wr == 0 ? acc[1][0][3][n][j] : acc[0][0][0][n][j];
            }
            asm volatile("s_waitcnt lgkmcnt(0)" ::: "memory"); __builtin_amdgcn_s_barrier(); asm volatile("" ::: "memory");
            const size_t tok0 = (size_t)u.pm * BM + 128 * wr + 8 * fr;
#pragma unroll
            for (int n = 0; n < 2; ++n) {
                const f32x4 w0 = *(const f32x4*)(f0 + cb0 + 4 * n), w1 = *(const f32x4*)(f0 + 2816 + cb0 + 4 * n), w2 = *(const f32x4*)(f0 + 2 * 2816 + cb0 + 4 * n), bs = *(const f32x4*)(f1 + cb0 + 4 * n);
                const f32x4 xo = *(const PG8_LAS f32x4*)(xch + (((1 - wr) * 4 + wc) * 4 + fq) * 8 + 4 * n);
                float res[8][4];
#pragma unroll
                for (int j = 0; j < 4; ++j) {
                    float g[8];
#pragma unroll
                    for (int i = 0; i < 8; ++i) g[i] = acc[i >> 2][0][i & 3][n][j];
                    float left = __builtin_bit_cast(float, __builtin_amdgcn_update_dpp(0, __builtin_bit_cast(int, g[7]), 0x111, 0xf, 0xf, true));
                    float right = __builtin_bit_cast(float, __builtin_amdgcn_update_dpp(0, __builtin_bit_cast(int, g[0]), 0x101, 0xf, 0xf, true));
                    if (ctx) { if (wr == 1 && fr == 0) left = xo[j]; if (wr == 0 && fr == 15) right = xo[j]; }
                    else { if ((fr & 7) == 0) left = 0.f; if ((fr & 7) == 7) right = 0.f; }
#pragma unroll
                    for (int i = 0; i < 8; ++i) { const float gm = i == 0 ? left : g[i - 1], gp_ = i == 7 ? right : g[i + 1];
                        const float c = bs[j] + w0[j] * gm + w1[j] * g[i] + w2[j] * gp_;
                        res[i][j] = c * fsigmoid(c) * acc[i >> 2][1][i & 3][n][j]; }
                }
#pragma unroll
                for (int i = 0; i < 8; ++i) { uint2 w; w.x = cvt_pk_bf16(res[i][0], res[i][1]); w.y = cvt_pk_bf16(res[i][2], res[i][3]);
                    *(uint2*)(O + (tok0 + i) * 2816 + cb0 + 4 * n) = w; }
            }
        } else if (kind == K_RESID) {
            const int col0 = u.pn * BM + wc * 32 + 4 * fq;
            const int slot = u.pm < 32 ? 0 : 1 + ((u.pm - 32) >> 3);
            const float* src = u.pm < 32 ? f0 : f1 - (size_t)8192 * 1024;
            const float* gp = f2 + (size_t)slot * 6144;
#pragma unroll
            for (int bj = 0; bj < 2; ++bj)
#pragma unroll
                for (int n = 0; n < 2; ++n) { const f32x4 gv = *(const f32x4*)(gp + col0 + bj * HALF + n * 16);
                    f32x4 xs[2][4];
#pragma unroll
                    for (int ai = 0; ai < 2; ++ai)
#pragma unroll
                        for (int m = 0; m < 4; ++m) xs[ai][m] = *(const f32x4*)(src + (size_t)(row0 + ai * HALF + m * 16) * 1024 + col0 + bj * HALF + n * 16);
                    asm volatile("" ::: "memory");
#pragma unroll
                    for (int ai = 0; ai < 2; ++ai)
#pragma unroll
                        for (int m = 0; m < 4; ++m) *(f32x4*)(xout + (size_t)(row0 + ai * HALF + m * 16) * 1024 + col0 + bj * HALF + n * 16) = xs[ai][m] + gv * acc[ai][bj][m][n];
                    asm volatile("" ::: "memory"); }
        } else if (kind == K_GATES) {
            const int d = u.pn >> 1, ch0 = (u.pn & 1) * HALF + wc * 32 + 8 * fq;
#pragma unroll
            for (int n = 0; n < 2; ++n) {
                const f32x4 bav = *(const f32x4*)(f0 + d * 256 + ch0 + 4 * n), bxv = *(const f32x4*)(f1 + d * 256 + ch0 + 4 * n), spv = *(const f32x4*)(f2 + d * 256 + ch0 + 4 * n);
#pragma unroll
                for (int ai = 0; ai < 2; ++ai)
#pragma unroll
                    for (int m = 0; m < 4; ++m) {
                        const size_t row = (size_t)(row0 + ai * HALF + m * 16);
                        const uint2 uu = *(const uint2*)(U + row * 256 + ch0 + 4 * n);
                        const float uv[4] = {bf_lo(uu.x), bf_hi(uu.x), bf_lo(uu.y), bf_hi(uu.y)};
                        float la2[4], bb[4];
#pragma unroll
                        for (int j = 0; j < 4; ++j) {
                            const float rg = fsigmoid(acc[ai][0][m][n][j] + bav[j]), ig = fsigmoid(acc[ai][1][m][n][j] + bxv[j]);
                            const float la = -8.0f * rg * spv[j];
                            la2[j] = la * 1.44269504089f; bb[j] = sqrtf(-expm1f(2.0f * la)) * ig * uv[j]; }
                        uint2 w0; w0.x = cvt_pk_bf16(la2[0], la2[1]); w0.y = cvt_pk_bf16(la2[2], la2[3]);
                        uint2 w1; w1.x = cvt_pk_bf16(bb[0], bb[1]); w1.y = cvt_pk_bf16(bb[2], bb[3]);
                        *(uint2*)(O + row * 1024 + d * 512 + ch0 + 4 * n) = w0;
                        *(uint2*)(O + row * 1024 + d * 512 + 256 + ch0 + 4 * n) = w1;
                        asm volatile("" ::: "memory");
                    }
            }
        } else {
            const int col0 = u.pn * BM + wc * 32 + 8 * fq;
#pragma unroll
            for (int bj = 0; bj < 2; ++bj) {
                int act = 0; float sc = 1.0f; f32x4 b0 = (f32x4){0.f, 0.f, 0.f, 0.f}, b1 = b0;
                if (kind == K_PROJ) { if (u.pn == 14 && bj == 1) continue; act = (u.pn == 6 && bj == 0) ? 1 : ((u.pn == 7 && bj == 0) ? 2 : 0); }
                if (kind == K_LORA) { const int grp = u.pn >> 1, cc = (col0 + bj * HALF) & 1023;
                    if (grp < 4) { const float* bp = (grp < 2 ? f0 : f1) + cc; b0 = *(const f32x4*)bp; b1 = *(const f32x4*)(bp + 4); act = 2; sc = grp < 2 ? 0.60653065971f : 1.0f; } }
#pragma unroll
                for (int ai = 0; ai < 2; ++ai)
#pragma unroll
                    for (int m = 0; m < 4; ++m) {
                        f32x4 v0 = acc[ai][bj][m][0] + b0, v1 = acc[ai][bj][m][1] + b1;
                        if (act == 1) {
#pragma unroll
                            for (int j = 0; j < 4; ++j) { v0[j] = ftanh(v0[j]); v1[j] = ftanh(v1[j]); } }
                        if (act == 2) {
#pragma unroll
                            for (int j = 0; j < 4; ++j) { v0[j] = fsigmoid(v0[j]) * sc; v1[j] = fsigmoid(v1[j]) * sc; } }
                        u32x4 w; w.x = cvt_pk_bf16(v0[0], v0[1]); w.y = cvt_pk_bf16(v0[2], v0[3]); w.z = cvt_pk_bf16(v1[0], v1[1]); w.w = cvt_pk_bf16(v1[2], v1[3]);
                        *(u32x4*)(O + (size_t)(row0 + ai * HALF + m * 16) * ldc + col0 + bj * HALF) = w;
                    }
            }
        }
    }
};
template <class Epi, class Sched, bool ALIGN_EPI = false, bool SP2 = false>
__device__ __forceinline__ void gemm_phase(PG8_LAS unsigned char* lds, const Gemm g, const Sched& S, const Epi& E) {
    int tid_ = threadIdx.x; asm volatile("" : "+v"(tid_));
    const int tid = tid_, wid = __builtin_amdgcn_readfirstlane(tid >> 6), lane = tid & 63, wr = wid >> 2, wc = wid & 3, fr = lane & 15, fq = lane >> 4;
    const int K = g.K, nt = K / BK;
    unsigned voffA[2], voffB[2];
    {
        const int b0 = tid * 16, st = b0 >> 10, sb = b0 & 1023, swz = sb ^ (((sb >> 9) & 1) << 5);
        const int R0 = (st >> 1) * 16 + (swz >> 6), C0 = (st & 1) * 32 + ((swz & 63) >> 1);
        const int Rb = E.perm() ? ((R0 & ~31) + perm32(R0 & 31)) : R0;
        const int Rt = g.rowperm ? (8 * (R0 & 15) + ((R0 >> 4) & 3)) : R0;
        voffA[0] = (unsigned)(Rt * g.lda + C0) * 2u; voffA[1] = voffA[0] + (unsigned)((g.rowperm ? 128 : 64) * g.lda) * 2u;
        voffB[0] = (unsigned)(Rb * K + C0) * 2u; voffB[1] = voffB[0] + (unsigned)(64 * K) * 2u;
    }
    const size_t kstep = (size_t)(BK * 2);
    const size_t hsA = (size_t)(g.rowperm ? 4 : HALF) * g.lda * 2, hsB = (size_t)HALF * K * 2;
    const size_t tsA = (size_t)BM * g.lda * 2, tsB = 2 * hsB;
    const unsigned ldsw = (unsigned)wid * 1024u;
    const int aoff = lds_byte(wr * 64 + fr, fq * 8), boff = lds_byte(wc * 32 + fr, fq * 8);
#define PG8_SA(b, h) (((b) * 2 + (h)) * HTB)
#define PG8_SB(b, h) ((4 + (b) * 2 + (h)) * HTB)
#define PG8_STAGE(bufoff, gbase, voff) do { _Pragma("unroll") for (int _i = 0; _i < 2; ++_i) \
        __builtin_amdgcn_global_load_lds((const unsigned*)((const char*)(gbase) + (voff)[_i]), (PG8_LAS unsigned*)(lds + (bufoff) + ldsw + _i * 8192), 16, 0, 0); } while (0)
#define PG8_LDA(dst, b, h) do { _Pragma("unroll") for (int m = 0; m < 4; ++m) _Pragma("unroll") for (int k = 0; k < 2; ++k) dst[m][k] = *(const PG8_LAS bf16x8*)(lds + PG8_SA(b, h) + aoff + m * 2048 + k * 1024); } while (0)
#define PG8_LDB(dst, b, h) do { _Pragma("unroll") for (int n = 0; n < 2; ++n) _Pragma("unroll") for (int k = 0; k < 2; ++k) dst[n][k] = *(const PG8_LAS bf16x8*)(lds + PG8_SB(b, h) + boff + n * 2048 + k * 1024); } while (0)
#define PG8_MMA(ai, bj, At, Bt) do { __builtin_amdgcn_s_setprio(1); _Pragma("unroll") for (int m = 0; m < 4; ++m) _Pragma("unroll") for (int n = 0; n < 2; ++n) _Pragma("unroll") for (int k = 0; k < 2; ++k) \
        acc[ai][bj][m][n] = __builtin_amdgcn_mfma_f32_16x16x32_bf16(Bt[n][k], At[m][k], acc[ai][bj][m][n], 0, 0, 0); __builtin_amdgcn_s_setprio(0); } while (0)
#define PG8_WAIT_V(n) asm volatile("s_waitcnt vmcnt(" #n ")" ::: "memory")
#define PG8_WAIT_L(n) asm volatile("s_waitcnt lgkmcnt(" #n ")" ::: "memory")
#define PG8_BAR __builtin_amdgcn_s_barrier()
#define PG8_SCHED __builtin_amdgcn_sched_barrier(0)
    Unit cur, nxt; int ui = 0;
    if (!S.next(0, cur)) return;
    f32x4 acc[2][2][4][2];
#pragma unroll
    for (int a = 0; a < 2; ++a)
#pragma unroll
        for (int b = 0; b < 2; ++b)
#pragma unroll
            for (int m = 0; m < 4; ++m)
#pragma unroll
                for (int n = 0; n < 2; ++n) acc[a][b][m][n] = (f32x4){0.f, 0.f, 0.f, 0.f};
    bf16x8 At[4][2], B0[2][2], B1[2][2];
    const char* cA = (const char*)g.A + (size_t)cur.pm * tsA; const char* cB = (const char*)g.Bt + (size_t)cur.pn * tsB;
    S.a_ready(cur);
    if constexpr (SP2) {
        PG8_STAGE(PG8_SB(0, 0), cB, voffB); PG8_STAGE(PG8_SB(0, 1), cB + hsB, voffB); PG8_STAGE(PG8_SA(0, 0), cA, voffA); PG8_STAGE(PG8_SA(0, 1), cA + hsA, voffA);
        if (wr == 1) PG8_BAR;
        PG8_WAIT_V(2); PG8_BAR;
        PG8_STAGE(PG8_SB(1, 0), cB + kstep, voffB); PG8_STAGE(PG8_SA(1, 0), cA + kstep, voffA); PG8_STAGE(PG8_SB(1, 1), cB + hsB + kstep, voffB);
        PG8_WAIT_V(6); PG8_BAR;
    } else {
        PG8_STAGE(PG8_SB(0, 0), cB, voffB); PG8_STAGE(PG8_SA(0, 0), cA, voffA); PG8_STAGE(PG8_SB(0, 1), cB + hsB, voffB); PG8_STAGE(PG8_SA(0, 1), cA + hsA, voffA);
        if (wr == 1) PG8_BAR;
        PG8_WAIT_V(4); PG8_BAR;
        PG8_STAGE(PG8_SB(1, 0), cB + kstep, voffB); PG8_STAGE(PG8_SA(1, 0), cA + kstep, voffA); PG8_STAGE(PG8_SB(1, 1), cB + hsB + kstep, voffB);
        PG8_WAIT_V(6); PG8_BAR;
    }
    for (;;) {
        const bool has_next = S.next(ui + 1, nxt);
        const char* nA = has_next ? (const char*)g.A + (size_t)nxt.pm * tsA : cA; const char* nB = has_next ? (const char*)g.Bt + (size_t)nxt.pn * tsB : cB;
        for (int t = 0; t < nt; t += 2) {
            const bool last = (t == nt - 2);
            const char* a1 = cA + (size_t)(t + 1) * kstep;
            const char* a2 = last ? nA : cA + (size_t)(t + 2) * kstep; const char* b2 = last ? nB : cB + (size_t)(t + 2) * kstep;
            const char* a3 = a2 + kstep; const char* b3 = b2 + kstep;
            if (last && has_next) S.a_ready(nxt);
            if constexpr (SP2) {
            PG8_LDB(B0, 0, 0); PG8_LDB(B1, 0, 1); PG8_SCHED; PG8_LDA(At, 0, 0); PG8_STAGE(PG8_SA(1, 1), a1 + hsA, voffA);
            PG8_WAIT_V(8); PG8_WAIT_L(0); PG8_BAR; PG8_MMA(0, 0, At, B0); PG8_MMA(0, 1, At, B1); PG8_BAR; PG8_SCHED;
            PG8_LDA(At, 0, 1); PG8_STAGE(PG8_SB(0, 0), b2, voffB); PG8_STAGE(PG8_SB(0, 1), b2 + hsB, voffB); PG8_STAGE(PG8_SA(0, 0), a2, voffA);
            PG8_WAIT_V(8); PG8_WAIT_L(0); PG8_BAR; PG8_MMA(1, 0, At, B0); PG8_MMA(1, 1, At, B1); PG8_BAR; PG8_SCHED;
            PG8_LDB(B0, 1, 0); PG8_LDB(B1, 1, 1); PG8_SCHED; PG8_LDA(At, 1, 0); PG8_STAGE(PG8_SA(0, 1), a2 + hsA, voffA);
            PG8_WAIT_V(8); PG8_WAIT_L(0); PG8_BAR; PG8_MMA(0, 0, At, B0); PG8_MMA(0, 1, At, B1); PG8_BAR; PG8_SCHED;
            PG8_LDA(At, 1, 1); PG8_STAGE(PG8_SB(1, 0), b3, voffB); PG8_STAGE(PG8_SB(1, 1), b3 + hsB, voffB); PG8_STAGE(PG8_SA(1, 0), a3, voffA);
            PG8_WAIT_V(8); PG8_WAIT_L(0); PG8_BAR; PG8_MMA(1, 0, At, B0); PG8_MMA(1, 1, At, B1); PG8_BAR; PG8_SCHED;
            } else {
            PG8_LDB(B0, 0, 0); PG8_SCHED; PG8_LDA(At, 0, 0); PG8_STAGE(PG8_SA(1, 1), a1 + hsA, voffA);
            PG8_WAIT_L(8); PG8_BAR; PG8_WAIT_L(0); PG8_MMA(0, 0, At, B0); PG8_BAR; PG8_SCHED;
            PG8_LDB(B1, 0, 1); PG8_STAGE(PG8_SB(0, 0), b2, voffB);
            PG8_BAR; PG8_WAIT_L(0); PG8_MMA(0, 1, At, B1); PG8_BAR;
            PG8_LDA(At, 0, 1); PG8_STAGE(PG8_SA(0, 0), a2, voffA);
            PG8_BAR; PG8_WAIT_L(0); PG8_MMA(1, 0, At, B0); PG8_BAR; PG8_SCHED;
            PG8_STAGE(PG8_SB(0, 1), b2 + hsB, voffB);
            PG8_WAIT_V(6); PG8_BAR; PG8_MMA(1, 1, At, B1); PG8_BAR;
            PG8_LDB(B0, 1, 0); PG8_SCHED; PG8_LDA(At, 1, 0); PG8_STAGE(PG8_SA(0, 1), a2 + hsA, voffA);
            PG8_WAIT_L(8); PG8_BAR; PG8_WAIT_L(0); PG8_MMA(0, 0, At, B0); PG8_BAR; PG8_SCHED;
            PG8_LDB(B1, 1, 1); PG8_STAGE(PG8_SB(1, 0), b3, voffB);
            PG8_BAR; PG8_WAIT_L(0); PG8_MMA(0, 1, At, B1); PG8_BAR;
            PG8_LDA(At, 1, 1); PG8_STAGE(PG8_SA(1, 0), a3, voffA);
            PG8_BAR; PG8_WAIT_L(0); PG8_MMA(1, 0, At, B0); PG8_BAR; PG8_SCHED;
            PG8_STAGE(PG8_SB(1, 1), b3 + hsB, voffB);
            PG8_WAIT_V(6); PG8_BAR; PG8_MMA(1, 1, At, B1); PG8_BAR;
            }
        }
        if constexpr (ALIGN_EPI) { if (wr == 0) PG8_BAR; }
        if constexpr (!Epi::AFTER_DRAIN) { E(acc, cur, wr, wc, fr, fq, lds); S.done(cur); }
        if (!has_next) break;
#pragma unroll
        for (int a = 0; a < 2; ++a)
#pragma unroll
            for (int b = 0; b < 2; ++b)
#pragma unroll
                for (int m = 0; m < 4; ++m)
#pragma unroll
                    for (int n = 0; n < 2; ++n) acc[a][b][m][n] = (f32x4){0.f, 0.f, 0.f, 0.f};
        cur = nxt; cA = nA; cB = nB; ++ui;
        if constexpr (ALIGN_EPI) { if (wr == 1) PG8_BAR; }
    }
    PG8_WAIT_V(0);
    if constexpr (!ALIGN_EPI) { if (wr == 0) PG8_BAR; }
    PG8_BAR;
    if constexpr (Epi::AFTER_DRAIN) { E.fused(acc, cur, wr, wc, fr, fq, lds, wid, lane); S.done(cur); }
#undef PG8_SA
#undef PG8_SB
#undef PG8_STAGE
#undef PG8_LDA
#undef PG8_LDB
#undef PG8_MMA
#undef PG8_WAIT_V
#undef PG8_WAIT_L
#undef PG8_BAR
#undef PG8_SCHED
}
}

using pg8::PP;
constexpr int NWAVES = 8, NTHR = 512;
constexpr int D = 1024, MTOK = 16384, MCTX = 8192, NB_CTX = 32, T_CTX = 256, NB_LAT = 4, T_LAT = 2048, NSLOT = 5;
constexpr int DFF = 2816, NPROJ = 3840, NLORA = 2560, KLORA = 384, NGATE = 1024, KGATE = 256, NGU = 5632;
constexpr int C_R = 0, C_K = 512, C_V = 1024, C_LORA = 1536, C_XB = 1920, C_GB = 2176, C_Q = 2432, C_FF = 2688, C_IV = 3200, C_OG = 3456;
constexpr size_t OUT_Y = 0, OUT_RWKV = (size_t)MTOK * D, OUT_LRU = OUT_RWKV + (size_t)32 * 2 * 2 * 8 * 4096, OUT_HGRN = OUT_LRU + (size_t)32 * 2 * 2 * 256, OUT_END = OUT_HGRN + (size_t)32 * 2 * 2 * 4 * 4096;
constexpr size_t MiB = 1u << 20;
constexpr size_t WS_CTL = 0, CTL_ZERO_BYTES = 64 * 1024;
constexpr size_t WS_MODP = 1 * MiB;
constexpr size_t WS_MOD = 3 * MiB;
constexpr size_t WS_SP = WS_MOD + 256 * 1024;
constexpr size_t WS_W = 4 * MiB;
constexpr size_t W_IN = 0, W_OUT = W_IN + (size_t)NPROJ * D * 2, W_GU = W_OUT + (size_t)D * D * 2, W_DOWN = W_GU + (size_t)NGU * D * 2,
                 W_LORA = W_DOWN + (size_t)D * DFF * 2, W_GATE = W_LORA + (size_t)NLORA * KLORA * 2, W_END = W_GATE + (size_t)NGATE * KGATE * 2;
static_assert(WS_W + W_END <= 34 * MiB, "weights");
constexpr size_t WS_R1 = 34 * MiB;
constexpr size_t WS_P = 66 * MiB;
constexpr size_t WS_L = 182 * MiB;
constexpr size_t WS_U = 262 * MiB;
constexpr size_t WS_G = 270 * MiB;
constexpr size_t WS_OR = 302 * MiB;
constexpr size_t WS_OH = 334 * MiB;
constexpr size_t WS_GU = 66 * MiB;
constexpr size_t WS_ACT = 242 * MiB;
constexpr size_t WS_END = 350 * MiB;
static_assert(WS_P + (size_t)MTOK * PP * 2 <= WS_L && WS_L + (size_t)MTOK * NLORA * 2 <= WS_U && WS_OH + (size_t)2 * MTOK * 256 * 2 <= WS_END && WS_GU + (size_t)MTOK * NGU * 2 <= WS_ACT && WS_ACT + (size_t)MTOK * DFF * 2 <= WS_END, "d_ws map");
constexpr int CW_BAR = 1024;
constexpr int CW_QUEUE = 8192;
static_assert((CW_QUEUE + 512) * 4 <= (int)CTL_ZERO_BYTES && CW_BAR + 3456 <= CW_QUEUE, "ctl");
constexpr int RING_OFF = 0, RING_BYTES = 131072;
constexpr int LDSCTL_OFF = RING_BYTES, MISC_OFF = LDSCTL_OFF + 320, PTBL_OFF = LDSCTL_OFF + 512, JDESC_OFF = LDSCTL_OFF + 1024;
constexpr int LDS_BYTES = 147456;

#define GAS __attribute__((address_space(1)))
#define LAS __attribute__((address_space(3)))
typedef unsigned short bf16;
typedef unsigned v4u __attribute__((ext_vector_type(4)));
typedef unsigned v2u __attribute__((ext_vector_type(2)));
typedef float f32x4 __attribute__((ext_vector_type(4)));
typedef float f32x2 __attribute__((ext_vector_type(2)));
typedef GAS unsigned gu32;
#define RLX_AGENT __ATOMIC_RELAXED, __HIP_MEMORY_SCOPE_AGENT
#define LDS_WAIT() asm volatile("s_waitcnt lgkmcnt(0)" ::: "memory")
#define VM_WAIT() asm volatile("s_waitcnt vmcnt(0)" ::: "memory")
using pg8::cvt_pk_bf16; using pg8::fsigmoid; using pg8::ftanh; using pg8::bf_lo; using pg8::bf_hi;
__device__ __forceinline__ float bf2f(bf16 h) { return __uint_as_float((unsigned)h << 16); }
__device__ __forceinline__ bf16 f2bf(float f) { return (bf16)(cvt_pk_bf16(f, 0.f) & 0xffffu); }
template <int CTRL> __device__ __forceinline__ float dpp_mov(float v) { return __builtin_bit_cast(float, __builtin_amdgcn_update_dpp(0, __builtin_bit_cast(int, v), CTRL, 0xf, 0xf, true)); }
__device__ __forceinline__ float rowsum16(float v) { v += dpp_mov<0xB1>(v); v += dpp_mov<0x4E>(v); v += dpp_mov<0x141>(v); v += dpp_mov<0x140>(v); return v; }
__device__ __forceinline__ float wave_sum(float v) {
#pragma unroll
    for (int o = 1; o < 64; o <<= 1) v += __shfl_xor(v, o);
    return v;
}
#define XB_TMO      128
#define XB_XCNT(j)  (256  + 64 * (j))
#define XB_XSUB(j)  (1280 + 64 * (j))
#define XB_XGEN(j)  (2304 + 64 * (j))
#define XB_TOP      3328
#define XB_TOPGEN   3392
#define XCD_BAR_WORDS 3456
#define XB_SPIN_CAP (1u << 18)

__device__ __forceinline__ unsigned xb_ld(unsigned* p)              { return __hip_atomic_load(p, __ATOMIC_RELAXED, __HIP_MEMORY_SCOPE_AGENT); }
__device__ __forceinline__ unsigned xb_add(unsigned* p, unsigned v) { return __hip_atomic_fetch_add(p, v, __ATOMIC_RELAXED, __HIP_MEMORY_SCOPE_AGENT); }
__device__ __forceinline__ unsigned xb_xcc_id() { return (unsigned)__builtin_amdgcn_s_getreg((3 << 11) | 20) & 0xFu; }
#define XB_SPIN(cond, bar) do { unsigned _sp = 0; while (cond) { __builtin_amdgcn_s_sleep(1); \
    if ((++_sp & 255u) == 0u) { if (xb_ld(&(bar)[XB_TMO])) break; if (_sp > XB_SPIN_CAP) { atomicAdd(&(bar)[XB_TMO], 1u); break; } } } } while (0)

struct XcdBarrier {
    unsigned* bar; unsigned x;
    volatile LAS unsigned* st;
};

__device__ __forceinline__ XcdBarrier xcd_barrier_post(unsigned* bar, volatile LAS unsigned* st) {
    XcdBarrier b; b.bar = bar; b.x = xb_xcc_id(); b.st = st;
    if (threadIdx.x == 0) (void)xb_add(&bar[XB_XCNT(b.x)], 1u);
    return b;
}
__device__ __forceinline__ void xcd_barrier_complete(unsigned* bar, unsigned x, unsigned& nloc, unsigned& nx) {
    const unsigned G = gridDim.x * gridDim.y * gridDim.z;
    unsigned sum, cnt, mine, sp = 0u;
    for (;;) {
        sum = 0u; cnt = 0u; mine = 0u;
#pragma unroll
        for (unsigned j = 0; j < 16; ++j) { const unsigned c = xb_ld(&bar[XB_XCNT(j)]); sum += c; cnt += (c > 0u) ? 1u : 0u; mine = (j == x) ? c : mine; }
        if (sum == G) break;
        __builtin_amdgcn_s_sleep(1);
        if ((++sp & 255u) == 0u) { if (xb_ld(&bar[XB_TMO])) break; if (sp > XB_SPIN_CAP) { atomicAdd(&bar[XB_TMO], 1u); break; } }
    }
    nloc = mine > 0u ? mine : 1u; nx = cnt > 0u ? cnt : 1u;
}

__device__ __forceinline__ void xcd_barrier(const XcdBarrier& b) {
    asm volatile("s_waitcnt vmcnt(0)" ::: "memory");
    __syncthreads();
    if (threadIdx.x == 0) {
        unsigned* bar = b.bar;
        __builtin_amdgcn_s_waitcnt(0);
        unsigned nloc = b.st[0], nx = b.st[1];
        if (nloc == 0u) { xcd_barrier_complete(bar, b.x, nloc, nx); b.st[0] = nloc; b.st[1] = nx; }
        const unsigned old = xb_add(&bar[XB_XSUB(b.x)], 1u);
        const unsigned gen = old / nloc;
        if (old + 1u == (gen + 1u) * nloc) {
            __builtin_amdgcn_fence(__ATOMIC_RELEASE, "agent");
            asm volatile("s_waitcnt vmcnt(0)" ::: "memory");
            const unsigned og = xb_add(&bar[XB_TOP], 1u);
            const unsigned tg = og / nx;
            if (og + 1u == (tg + 1u) * nx) xb_add(&bar[XB_TOPGEN], 1u);
            else XB_SPIN(xb_ld(&bar[XB_TOPGEN]) == tg, bar);
            __builtin_amdgcn_fence(__ATOMIC_ACQUIRE, "agent");
            xb_add(&bar[XB_XGEN(b.x)], 1u);
            asm volatile("s_waitcnt vmcnt(0)" ::: "memory");
        } else {
            XB_SPIN(xb_ld(&bar[XB_XGEN(b.x)]) == gen, bar);
            __builtin_amdgcn_fence(__ATOMIC_ACQUIRE, "agent");
            asm volatile("s_waitcnt vmcnt(0)" ::: "memory");
        }
    }
    __syncthreads();
}


struct Args { const float* in[38]; float* out; unsigned char* ws; int ph_lo, ph_hi; };
enum InIdx { I_XP = 0, I_XS, I_SRWKV, I_SLRU, I_SHGRN, I_C, I_CCTX, I_ADAW, I_ADAB, I_NMIXG, I_NFFNG, I_WIN, I_WOUT, I_W0, I_WUP, I_A0, I_AUP, I_GUP, I_KK, I_KA, I_RK, I_LNW, I_LNB,
             I_LCW, I_LCB, I_LWA, I_LBA, I_LWX, I_LBX, I_LLAM, I_HLB, I_HNG, I_FWG, I_FWU, I_FCW, I_FCB, I_FWD, I_FING };

struct InTbl { const LAS unsigned long long* t;
    __device__ __forceinline__ const float* operator[](int i) const { const unsigned long long v = t[i];
        const unsigned lo = __builtin_amdgcn_readfirstlane((unsigned)v), hi = __builtin_amdgcn_readfirstlane((unsigned)(v >> 32)); return (const float*)(const __attribute__((address_space(1))) float*)(((unsigned long long)hi << 32) | lo); } };
struct Ctx { InTbl in; float* out; unsigned char* ws; };
__device__ __forceinline__ int slot_of_row(int r) { return r < MCTX ? 0 : 1 + ((r - MCTX) >> 11); }

__device__ __forceinline__ void transpose_item(const float* W, int K, int N, bf16* WT, int item, int drow_mode, LAS float* scr, int lane) {
    const int nblk = N / 32, kb = item / nblk, nb = item % nblk, k0 = 64 * kb, n0 = 32 * nb;
    int drow0 = n0;
    if (drow_mode == 1) drow0 = (n0 >> 7) * 256 + (n0 & 127);
    if (drow_mode == 2) drow0 = (n0 >> 7) * 256 + 128 + (n0 & 127);
#pragma unroll 8
    for (int i = 0; i < 32; ++i) { const int kk = 2 * i + (lane >> 5); scr[kk * 33 + (lane & 31)] = W[(size_t)(k0 + kk) * N + n0 + (lane & 31)]; }
    LDS_WAIT();
    const int c = lane & 7;
#pragma unroll
    for (int j = 0; j < 4; ++j) { const int n = (lane >> 3) + 8 * j; const LAS float* s = scr + (8 * c) * 33 + n;
        v4u o; o.x = cvt_pk_bf16(s[0 * 33], s[1 * 33]); o.y = cvt_pk_bf16(s[2 * 33], s[3 * 33]); o.z = cvt_pk_bf16(s[4 * 33], s[5 * 33]); o.w = cvt_pk_bf16(s[6 * 33], s[7 * 33]);
        *(v4u*)(WT + (size_t)(drow0 + n) * K + k0 + 8 * c) = o; }
    LDS_WAIT();
}
__device__ __forceinline__ void convert_weights(const Ctx& a, int l, LAS unsigned char* lds, int gw, int NGW, int wave, int lane, int gtid, int NGT) {
    LAS float* scr = (LAS float*)(lds + wave * 8704);
    unsigned char* wb = a.ws + WS_W;
    constexpr int I_IN = (D / 64) * (PP / 32), I_OUT = (D / 64) * (D / 32), I_G = (D / 64) * (DFF / 32), I_DN = (DFF / 64) * (D / 32);
    constexpr int NITEMS = I_IN + I_OUT + 2 * I_G + I_DN;
    const float* p_win = a.in[I_WIN]; const float* p_wout = a.in[I_WOUT]; const float* p_fwg = a.in[I_FWG]; const float* p_fwu = a.in[I_FWU]; const float* p_fwd = a.in[I_FWD];
    for (int it = gw; it < NITEMS; it += NGW) {
        int r = it;
        if (r < I_IN) { transpose_item(p_win + (size_t)l * D * PP, D, PP, (bf16*)(wb + W_IN), r, 0, scr, lane); continue; } r -= I_IN;
        if (r < I_OUT) { transpose_item(p_wout + (size_t)l * D * D, D, D, (bf16*)(wb + W_OUT), r, 0, scr, lane); continue; } r -= I_OUT;
        if (r < I_G) { transpose_item(p_fwg + (size_t)l * D * DFF, D, DFF, (bf16*)(wb + W_GU), r, 1, scr, lane); continue; } r -= I_G;
        if (r < I_G) { transpose_item(p_fwu + (size_t)l * D * DFF, D, DFF, (bf16*)(wb + W_GU), r, 2, scr, lane); continue; } r -= I_G;
        transpose_item(p_fwd + (size_t)l * DFF * D, DFF, D, (bf16*)(wb + W_DOWN), r, 0, scr, lane);
    }
    constexpr int CH_Z = (NPROJ - PP) * D / 8, CH_L = NLORA * KLORA / 8, CH_G = NGATE * KGATE / 8;
    const float* wup = a.in[I_WUP] + (size_t)l * 2 * 64 * 512; const float* aup = a.in[I_AUP] + (size_t)l * 2 * 64 * 512; const float* gup = a.in[I_GUP] + (size_t)l * 128 * 512;
    const float* lwa = a.in[I_LWA] + (size_t)l * 2 * 4 * 64 * 64; const float* lwx = a.in[I_LWX] + (size_t)l * 2 * 4 * 64 * 64;
    for (int c = gtid; c < CH_Z + CH_L + CH_G; c += NGT) {
        float v[8];
#pragma unroll
        for (int j = 0; j < 8; ++j) v[j] = 0.f;
        bf16* dst;
        if (c < CH_Z) { dst = (bf16*)(wb + W_IN) + (size_t)PP * D + (size_t)c * 8; }
        else if (c < CH_Z + CH_L) {
            const int e = (c - CH_Z) * 8, n = e / KLORA, k0 = e % KLORA; dst = (bf16*)(wb + W_LORA) + e;
            const int grp = n >> 9, cc = n & 511;
            if (grp < 4) { if ((k0 >> 6) == grp) { const float* src = (grp < 2 ? wup : aup) + (size_t)((grp & 1) * 64 + (k0 & 63)) * 512 + cc;
#pragma unroll
                    for (int j = 0; j < 8; ++j) v[j] = src[(size_t)j * 512]; } }
            else if (k0 >= 256) { const float* src = gup + (size_t)(k0 - 256) * 512 + cc;
#pragma unroll
                    for (int j = 0; j < 8; ++j) v[j] = src[(size_t)j * 512]; }
        } else {
            const int e = (c - CH_Z - CH_L) * 8, n = e / KGATE, k0 = e % KGATE; dst = (bf16*)(wb + W_GATE) + e;
            const int pn = n >> 8, d = pn >> 1, ch = (pn & 1) * 128 + (n & 127), blk = ch >> 6, jj = ch & 63;
            if ((k0 >> 6) == blk) { const float* src = (((n >> 7) & 1) ? lwx : lwa) + (size_t)(((d * 4 + blk) * 64 + (k0 & 63)) * 64) + jj;
#pragma unroll
                for (int j = 0; j < 8; ++j) v[j] = src[(size_t)j * 64]; }
        }
        v4u o; o.x = cvt_pk_bf16(v[0], v[1]); o.y = cvt_pk_bf16(v[2], v[3]); o.z = cvt_pk_bf16(v[4], v[5]); o.w = cvt_pk_bf16(v[6], v[7]);
        *(v4u*)dst = o;
    }
    if (gtid < 512) { const float lam = a.in[I_LLAM][l * 512 + gtid]; ((float*)(a.ws + WS_SP))[l * 512 + gtid] = log1pf(__expf(-lam)); }
}
__device__ __forceinline__ void mod_partials(const Ctx& a, LAS unsigned char* lds, int bid, int G, int tid) {
    LAS float* sc = (LAS float*)lds;
    const float* cctx = a.in[I_CCTX]; const float* cc = a.in[I_C]; const float* adaw = a.in[I_ADAW];
    for (int it = bid; it < 2 * 12 * 8; it += G) {
        const int l = it / 96, nb = (it % 96) / 8, ks = it % 8;
        __syncthreads();
        for (int e = tid; e < NSLOT * 128; e += NTHR) { const int s = e >> 7, k = ks * 128 + (e & 127);
            const float c = s == 0 ? cctx[k] : cc[(s - 1) * D + k]; sc[e] = c * fsigmoid(c); }
        __syncthreads();
        const int n = nb * 512 + tid; const float* wp = adaw + ((size_t)l * D + ks * 128) * 6144 + n;
        float acc[NSLOT];
#pragma unroll
        for (int s = 0; s < NSLOT; ++s) acc[s] = 0.f;
#pragma unroll 8
        for (int k = 0; k < 128; ++k) { const float w = wp[(size_t)k * 6144];
#pragma unroll
            for (int s = 0; s < NSLOT; ++s) acc[s] += sc[s * 128 + k] * w; }
        float* pp = (float*)(a.ws + WS_MODP) + ((size_t)(l * 8 + ks) * NSLOT) * 6144 + n;
#pragma unroll
        for (int s = 0; s < NSLOT; ++s) pp[(size_t)s * 6144] = acc[s];
    }
    __syncthreads();
}
__device__ __forceinline__ void mod_finalize(const Ctx& a, int gtid, int NGT) {
    const float* adab = a.in[I_ADAB];
    for (int e = gtid; e < 2 * NSLOT * 6144; e += NGT) { const int l = e / (NSLOT * 6144), r = e % (NSLOT * 6144), n = r % 6144;
        float s = adab[l * 6144 + n]; const float* pp = (const float*)(a.ws + WS_MODP) + (size_t)l * 8 * NSLOT * 6144 + r;
#pragma unroll
        for (int ks = 0; ks < 8; ++ks) s += pp[(size_t)ks * NSLOT * 6144];
        ((float*)(a.ws + WS_MOD))[e] = s; }
}

__device__ __forceinline__ void phase_norm(const Ctx& a, LAS unsigned char* lds, int l, int which, bool from_partials, bool x_from_inputs, int bid, int G, int tid, int wave, int lane) {
    LAS float* gs = (LAS float*)lds; LAS float* sh = gs + D;
    const float* gw = a.in[which ? I_NFFNG : I_NMIXG] + l * D; const float* adab = a.in[I_ADAB]; const float* xp = a.in[I_XP]; const float* xs = a.in[I_XS];
    bf16* H = (bf16*)(a.ws + WS_R1);
    for (int rb = bid; rb < MTOK / 64; rb += G) {
        const int r0 = rb * 64, slot = slot_of_row(r0);
        __syncthreads();
        for (int c = tid; c < D; c += NTHR) {
            float shv, scv;
            if (from_partials) {
                shv = adab[l * 6144 + (which * 3 + 0) * D + c]; scv = adab[l * 6144 + (which * 3 + 1) * D + c];
                const float* pp = (const float*)(a.ws + WS_MODP) + ((size_t)(l * 8) * NSLOT + slot) * 6144;
#pragma unroll
                for (int ks = 0; ks < 8; ++ks) { shv += pp[(size_t)ks * NSLOT * 6144 + (which * 3 + 0) * D + c]; scv += pp[(size_t)ks * NSLOT * 6144 + (which * 3 + 1) * D + c]; }
            } else {
                const float* mp = (const float*)(a.ws + WS_MOD) + ((size_t)l * NSLOT + slot) * 6144;
                shv = mp[(which * 3 + 0) * D + c]; scv = mp[(which * 3 + 1) * D + c];
            }
            gs[c] = gw[c] * (1.0f + scv); sh[c] = shv;
        }
        __syncthreads();
        for (int i = 0; i < 8; ++i) {
            const int r = r0 + wave * 8 + i;
            const float* xr = x_from_inputs ? (r < MCTX ? xp + (size_t)r * D : xs + (size_t)(r - MCTX) * D) : a.out + (size_t)r * D;
            f32x4 v[4]; float ss = 0.f;
#pragma unroll
            for (int q = 0; q < 4; ++q) { v[q] = *(const f32x4*)(xr + 4 * lane + 256 * q); ss += (v[q].x * v[q].x + v[q].y * v[q].y) + (v[q].z * v[q].z + v[q].w * v[q].w); }
            const float rinv = rsqrtf(wave_sum(ss) * (1.0f / D) + 1e-6f);
#pragma unroll
            for (int q = 0; q < 4; ++q) { const int c = 4 * lane + 256 * q; const f32x4 g4 = *(const LAS f32x4*)(gs + c), s4 = *(const LAS f32x4*)(sh + c);
                const f32x4 o = v[q] * rinv * g4 + s4; v2u w; w.x = cvt_pk_bf16(o.x, o.y); w.y = cvt_pk_bf16(o.z, o.w);
                *(v2u*)(H + (size_t)r * D + c) = w; }
        }
    }
    __syncthreads();
}
__device__ __forceinline__ void phase_final_norm(const Ctx& a, int gw, int NGW, int lane) {
    const float* g = a.in[I_FING];
    f32x4 g4[4];
#pragma unroll
    for (int q = 0; q < 4; ++q) g4[q] = *(const f32x4*)(g + 4 * lane + 256 * q);
    for (int r = gw; r < MTOK; r += NGW) {
        float* xr = a.out + (size_t)r * D; f32x4 v[4]; float ss = 0.f;
#pragma unroll
        for (int q = 0; q < 4; ++q) { v[q] = *(const f32x4*)(xr + 4 * lane + 256 * q); ss += (v[q].x * v[q].x + v[q].y * v[q].y) + (v[q].z * v[q].z + v[q].w * v[q].w); }
        const float rinv = rsqrtf(wave_sum(ss) * (1.0f / D) + 1e-6f);
#pragma unroll
        for (int q = 0; q < 4; ++q) *(f32x4*)(xr + 4 * lane + 256 * q) = v[q] * rinv * g4[q];
    }
}
__device__ __forceinline__ void phase_lru_conv(const Ctx& a, int l, int gtid, int NGT) {
    const bf16* P = (const bf16*)(a.ws + WS_P); bf16* U = (bf16*)(a.ws + WS_U);
    const float* cw = a.in[I_LCW] + l * 4 * 256; const float* cb = a.in[I_LCB] + l * 256;
    for (int it = gtid; it < MTOK * 32; it += NGT) {
        const int r = it >> 5, c0 = (it & 31) * 8;
        const int tt = r < MCTX ? (r & (T_CTX - 1)) : ((r - MCTX) & (T_LAT - 1)), Ts = r < MCTX ? T_CTX : T_LAT;
        float acc[8];
#pragma unroll
        for (int j = 0; j < 8; ++j) acc[j] = cb[c0 + j];
#pragma unroll
        for (int k = 0; k < 4; ++k) { const int t2 = tt + k - 2; if (t2 < 0 || t2 >= Ts) continue;
            const v4u x = *(const v4u*)(P + (size_t)(r + k - 2) * PP + C_XB + c0);
            const float xv[8] = {bf_lo(x.x), bf_hi(x.x), bf_lo(x.y), bf_hi(x.y), bf_lo(x.z), bf_hi(x.z), bf_lo(x.w), bf_hi(x.w)};
#pragma unroll
            for (int j = 0; j < 8; ++j) acc[j] += cw[k * 256 + c0 + j] * xv[j]; }
        v4u o; o.x = cvt_pk_bf16(acc[0], acc[1]); o.y = cvt_pk_bf16(acc[2], acc[3]); o.z = cvt_pk_bf16(acc[4], acc[5]); o.w = cvt_pk_bf16(acc[6], acc[7]);
        *(v4u*)(U + (size_t)r * 256 + c0) = o;
    }
}

constexpr int SCAN_BUF_BYTES = 49152;
constexpr int SCAN_OST_OFF = 2 * SCAN_BUF_BYTES, SCAN_OST_BYTES = 8192;
static_assert(SCAN_OST_OFF + 2 * SCAN_OST_BYTES <= RING_BYTES, "scan LDS");
template <int CTRL> __device__ __forceinline__ float dpp_add(float v) { return v + dpp_mov<CTRL>(v); }
__device__ __forceinline__ float fma_s(float a, float b, float c) { float d; asm("v_fma_f32 %0, %1, %2, %3" : "=v"(d) : "v"(a), "v"(b), "v"(c)); return d; }
__device__ __forceinline__ float fnma_s(float a, float b, float c) { float d; asm("v_fma_f32 %0, -%1, %2, %3" : "=v"(d) : "v"(a), "v"(b), "v"(c)); return d; }
__device__ __forceinline__ float mul_s(float a, float b) { float d; asm("v_mul_f32 %0, %1, %2" : "=v"(d) : "v"(a), "v"(b)); return d; }
__device__ __forceinline__ float add_s(float a, float b) { float d; asm("v_add_f32 %0, %1, %2" : "=v"(d) : "v"(a), "v"(b)); return d; }
__device__ __forceinline__ float rowsum8(float v) { v = dpp_add<0xB1>(v); v = dpp_add<0x4E>(v); v = dpp_add<0x141>(v); return v; }

struct SeqInfo { int row0, T, bl; bool latent; };
__device__ __forceinline__ SeqInfo seq_info(int b) { SeqInfo s; s.latent = b >= NB_CTX; s.bl = s.latent ? b - NB_CTX : b; s.row0 = s.latent ? MCTX + s.bl * T_LAT : b * T_CTX; s.T = s.latent ? T_LAT : T_CTX; return s; }
struct Combo { int b, h, d; };

template <int MIX  , int RV, int NW>
__device__ __forceinline__ void scan_unit(const Ctx& a, LAS unsigned char* lds, int l, Combo c0_, Combo c1_, int rh, int tid, int wave, int lane) {
    constexpr int NCOMBO = RV == 2 ? 2 : 1, TCX = 32 / NCOMBO, NARR = MIX == 0 ? 6 : 4, VA = NARR - 1;
    constexpr int ROWS_U = NW == 4 ? 32 : 64, VPT = ROWS_U / 16;
    constexpr int CFL = NARR * TCX * 64;
    static_assert(NCOMBO * CFL * 4 <= SCAN_BUF_BYTES && NCOMBO * TCX * 64 * 4 <= SCAN_OST_BYTES, "scan LDS carve");
    const bf16* P = (const bf16*)(a.ws + WS_P); const bf16* L = (const bf16*)(a.ws + WS_L);
    const int pslot = NCOMBO == 2 ? tid >> 8 : 0, tok = NCOMBO == 2 ? (tid >> 4) & 15 : tid >> 4, cq = tid & 15;
    const Combo pc = pslot ? c1_ : c0_;
    const SeqInfo psq = seq_info(pc.b);
    const int nch = psq.T / TCX, c0 = pc.h * 64 + 4 * cq;
    float pc0[4], pc1[4];
    { const float* t0 = MIX == 0 ? a.in[I_KK] : a.in[I_HLB]; const float* t1 = MIX == 0 ? a.in[I_KA] : t0;
#pragma unroll
    for (int j = 0; j < 4; ++j) {
        if (MIX == 0) { pc0[j] = t0[l * 512 + c0 + j]; pc1[j] = t1[l * 512 + c0 + j]; }
        else { float lb = 0.f; if (l == 1) lb = fsigmoid(t0[(pc.d * 2 + 1) * 256 + c0 + j] - t0[(pc.d * 2 + 0) * 256 + c0 + j]); pc0[j] = lb; pc1[j] = 1.0f - lb; }
    } }
    v2u raw[5];
    auto prep_load = [&](int c) {
        const int t0 = pc.d == 0 ? c * TCX : psq.T - (c + 1) * TCX; const size_t row = (size_t)(psq.row0 + t0 + tok);
        if (MIX == 0) {
            raw[0] = *(const v2u*)(P + row * PP + C_R + c0); raw[1] = *(const v2u*)(P + row * PP + C_K + c0); raw[2] = *(const v2u*)(P + row * PP + C_V + c0);
            raw[3] = *(const v2u*)(L + row * NLORA + pc.d * 512 + c0); raw[4] = *(const v2u*)(L + row * NLORA + 1024 + pc.d * 512 + c0);
        } else {
            raw[0] = *(const v2u*)(P + row * PP + C_Q + c0); raw[1] = *(const v2u*)(P + row * PP + C_FF + pc.d * 256 + c0); raw[2] = *(const v2u*)(P + row * PP + C_IV + c0);
        }
    };
    auto prep_store = [&](int bufi) {
        LAS float* buf = (LAS float*)(lds + bufi * SCAN_BUF_BYTES) + pslot * CFL + tok * 64 + 4 * cq;
        if (MIX == 0) {
            const f32x4 r4 = {bf_lo(raw[0].x), bf_hi(raw[0].x), bf_lo(raw[0].y), bf_hi(raw[0].y)};
            const f32x4 k4 = {bf_lo(raw[1].x), bf_hi(raw[1].x), bf_lo(raw[1].y), bf_hi(raw[1].y)};
            const f32x4 v4 = {bf_lo(raw[2].x), bf_hi(raw[2].x), bf_lo(raw[2].y), bf_hi(raw[2].y)};
            const f32x4 e4 = {bf_lo(raw[3].x), bf_hi(raw[3].x), bf_lo(raw[3].y), bf_hi(raw[3].y)};
            const f32x4 a4 = {bf_lo(raw[4].x), bf_hi(raw[4].x), bf_lo(raw[4].y), bf_hi(raw[4].y)};
            f32x4 kf, w4, b4, kd;
#pragma unroll
            for (int j = 0; j < 4; ++j) kf[j] = k4[j] * pc0[j];
            const float ss = rowsum16((kf[0] * kf[0] + kf[1] * kf[1]) + (kf[2] * kf[2] + kf[3] * kf[3]));
            const float rn = rsqrtf(ss + 1e-12f);
#pragma unroll
            for (int j = 0; j < 4; ++j) { kf[j] *= rn; w4[j] = __builtin_amdgcn_exp2f(-1.44269504089f * e4[j]); b4[j] = kf[j] * a4[j]; kd[j] = k4[j] * (1.0f + (a4[j] - 1.0f) * pc1[j]); }
            *(LAS f32x4*)(buf + 0 * TCX * 64) = kf; *(LAS f32x4*)(buf + 1 * TCX * 64) = w4; *(LAS f32x4*)(buf + 2 * TCX * 64) = b4;
            *(LAS f32x4*)(buf + 3 * TCX * 64) = kd; *(LAS f32x4*)(buf + 4 * TCX * 64) = r4; *(LAS f32x4*)(buf + 5 * TCX * 64) = v4;
        } else {
            const f32x4 q4 = {bf_lo(raw[0].x), bf_hi(raw[0].x), bf_lo(raw[0].y), bf_hi(raw[0].y)};
            const f32x4 g4 = {bf_lo(raw[1].x), bf_hi(raw[1].x), bf_lo(raw[1].y), bf_hi(raw[1].y)};
            const f32x4 v4 = {bf_lo(raw[2].x), bf_hi(raw[2].x), bf_lo(raw[2].y), bf_hi(raw[2].y)};
            f32x4 f4, kx, qs;
#pragma unroll
            for (int j = 0; j < 4; ++j) { f4[j] = pc0[j] + pc1[j] * fsigmoid(g4[j]); kx[j] = 1.0f - f4[j]; qs[j] = q4[j] * fsigmoid(q4[j]); }
            *(LAS f32x4*)(buf + 0 * TCX * 64) = f4; *(LAS f32x4*)(buf + 1 * TCX * 64) = kx; *(LAS f32x4*)(buf + 2 * TCX * 64) = qs; *(LAS f32x4*)(buf + 3 * TCX * 64) = v4;
        }
    };
    const bool scanner = wave < NW;
    const int sslot = NCOMBO == 2 ? wave >> 2 : 0, wcm = NCOMBO == 2 ? wave & 3 : wave;
    const Combo sc = sslot ? c1_ : c0_;
    const SeqInfo ssq = seq_info(sc.b);
    const int lv = lane >> 3, lk = lane & 7;
    const int grow = rh * 32 + wcm * 8 * RV + lv * RV;
    const int rloc = grow - rh * 32;
    f32x4 S[RV][2];
    if (scanner) {
        if (ssq.latent) {
            const float* stp = MIX == 0 ? a.in[I_SRWKV] : a.in[I_SHGRN];
#pragma unroll
            for (int j = 0; j < RV; ++j) {
                if (MIX == 0) { const float* st = stp + ((((size_t)ssq.bl * 2 + l) * 2 + sc.d) * 8 + sc.h) * 4096 + (size_t)(grow + j) * 64 + 8 * lk; S[j][0] = *(const f32x4*)st; S[j][1] = *(const f32x4*)(st + 4); }
                else { const float* st = stp + ((((size_t)ssq.bl * 2 + l) * 2 + sc.d) * 4 + sc.h) * 4096 + (grow + j);
                    S[j][0] = (f32x4){st[(8 * lk + 0) * 64], st[(8 * lk + 1) * 64], st[(8 * lk + 2) * 64], st[(8 * lk + 3) * 64]};
                    S[j][1] = (f32x4){st[(8 * lk + 4) * 64], st[(8 * lk + 5) * 64], st[(8 * lk + 6) * 64], st[(8 * lk + 7) * 64]}; }
            }
        } else {
#pragma unroll
            for (int j = 0; j < RV; ++j) { S[j][0] = (f32x4){0.f, 0.f, 0.f, 0.f}; S[j][1] = S[j][0]; }
        }
    }
    constexpr int OPITCH = MIX == 0 ? 512 : 256;
    auto write_out = [&](int c) {
        const int t0 = pc.d == 0 ? c * TCX : psq.T - (c + 1) * TCX;
        const LAS float* ost = (const LAS float*)(lds + SCAN_OST_OFF + (c & 1) * SCAN_OST_BYTES) + pslot * TCX * 64 + tok * 64 + cq * VPT;
        bf16* Od = (MIX == 0 ? (bf16*)(a.ws + WS_OR) : (bf16*)(a.ws + WS_OH)) + (size_t)pc.d * MTOK * OPITCH;
        bf16* op = Od + (size_t)(psq.row0 + t0 + tok) * OPITCH + pc.h * 64 + rh * 32 + cq * VPT;
        if (VPT == 2) { *(unsigned*)op = cvt_pk_bf16(ost[0], ost[1]); }
        else { v2u w; w.x = cvt_pk_bf16(ost[0], ost[1]); w.y = cvt_pk_bf16(ost[2], ost[3]); *(v2u*)op = w; }
    };
    struct Ops { f32x4 x[MIX == 0 ? 5 : 3][2]; float vv[RV]; };
    auto ld_ops = [&](Ops& o, const LAS float* buf, int i) {
        const LAS float* bp = buf + i * 64 + 8 * lk;
#pragma unroll
        for (int q = 0; q < (MIX == 0 ? 5 : 3); ++q) { o.x[q][0] = *(const LAS f32x4*)(bp + q * TCX * 64); o.x[q][1] = *(const LAS f32x4*)(bp + q * TCX * 64 + 4); }
#pragma unroll
        for (int j = 0; j < RV; ++j) o.vv[j] = buf[VA * TCX * 64 + i * 64 + grow + j];
    };
    float keep[RV];
    auto do_step = [&](const Ops& o, int s8) {
#pragma unroll
        for (int j = 0; j < RV; ++j) {
            f32x2 s[4] = {{S[j][0].x, S[j][0].y}, {S[j][0].z, S[j][0].w}, {S[j][1].x, S[j][1].y}, {S[j][1].z, S[j][1].w}};
#define OPK(q, p) ((f32x2){o.x[q][(p) >> 1][((p) & 1) * 2], o.x[q][(p) >> 1][((p) & 1) * 2 + 1]})
            float ov;
            if (MIX == 0) {
                f32x2 t = s[0] * OPK(0, 0); t = s[1] * OPK(0, 1) + t; t = s[2] * OPK(0, 2) + t; t = s[3] * OPK(0, 3) + t;
                f32x2 u[4];
#pragma unroll
                for (int p = 0; p < 4; ++p) u[p] = OPK(3, p) * o.vv[j];
                const float sa = rowsum8(t.x + t.y);
#pragma unroll
                for (int p = 0; p < 4; ++p) { s[p] = s[p] * OPK(1, p) + u[p]; s[p] = s[p] - OPK(2, p) * sa; }
                f32x2 q = s[0] * OPK(4, 0); q = s[1] * OPK(4, 1) + q; q = s[2] * OPK(4, 2) + q; q = s[3] * OPK(4, 3) + q;
                ov = rowsum8(q.x + q.y);
            } else {
#pragma unroll
                for (int p = 0; p < 4; ++p) s[p] = s[p] * OPK(0, p) + OPK(1, p) * o.vv[j];
                f32x2 q = s[0] * OPK(2, 0); q = s[1] * OPK(2, 1) + q; q = s[2] * OPK(2, 2) + q; q = s[3] * OPK(2, 3) + q;
                ov = rowsum8(q.x + q.y);
            }
#undef OPK
            S[j][0] = (f32x4){s[0].x, s[0].y, s[1].x, s[1].y}; S[j][1] = (f32x4){s[2].x, s[2].y, s[3].x, s[3].y};
            keep[j] = (lk == s8) ? ov : keep[j];
        }
    };
    __syncthreads();
    prep_load(0); prep_store(0);
    __syncthreads();
    for (int c = 0; c < nch; ++c) {
        if (c + 1 < nch) prep_load(c + 1);
        if (c > 0) write_out(c - 1);
        if (scanner) {
            const LAS float* buf = (const LAS float*)(lds + (c & 1) * SCAN_BUF_BYTES) + sslot * CFL;
            LAS float* ost = (LAS float*)(lds + SCAN_OST_OFF + (c & 1) * SCAN_OST_BYTES) + sslot * TCX * 64;
            const int i0 = sc.d == 0 ? 0 : TCX - 1, di = sc.d == 0 ? 1 : -1;
            Ops oa, ob;
            ld_ops(oa, buf, i0);
#pragma unroll 1
            for (int g = 0; g < TCX / 8; ++g) {
                const int ig = i0 + di * 8 * g;
#pragma unroll
                for (int j = 0; j < RV; ++j) keep[j] = 0.f;
#pragma unroll
                for (int s = 0; s < 8; s += 2) {
                    ld_ops(ob, buf, ig + di * (s + 1));
                    do_step(oa, s);
                    if (s + 2 < 8 || g + 1 < TCX / 8) ld_ops(oa, buf, ig + di * (s + 2));
                    do_step(ob, s + 1);
                }
#pragma unroll
                for (int j = 0; j < RV; ++j) ost[(ig + di * lk) * 64 + rloc + j] = keep[j];
            }
        }
        if (c + 1 < nch) prep_store((c + 1) & 1);
        __syncthreads();
    }
    write_out(nch - 1);
    if (scanner && !ssq.latent) {
#pragma unroll
        for (int j = 0; j < RV; ++j) {
            if (MIX == 0) { float* st = a.out + OUT_RWKV + ((((size_t)ssq.bl * 2 + l) * 2 + sc.d) * 8 + sc.h) * 4096 + (size_t)(grow + j) * 64 + 8 * lk; *(f32x4*)st = S[j][0]; *(f32x4*)(st + 4) = S[j][1]; }
            else { float* st = a.out + OUT_HGRN + ((((size_t)ssq.bl * 2 + l) * 2 + sc.d) * 4 + sc.h) * 4096 + (grow + j);
                st[(8 * lk + 0) * 64] = S[j][0].x; st[(8 * lk + 1) * 64] = S[j][0].y; st[(8 * lk + 2) * 64] = S[j][0].z; st[(8 * lk + 3) * 64] = S[j][0].w;
                st[(8 * lk + 4) * 64] = S[j][1].x; st[(8 * lk + 5) * 64] = S[j][1].y; st[(8 * lk + 6) * 64] = S[j][1].z; st[(8 * lk + 7) * 64] = S[j][1].w; }
        }
    }
}

__device__ __forceinline__ float gelu_tanh(float x) { return 0.5f * x * (1.0f + ftanh(0.7978845608f * (x + 0.044715f * x * x * x))); }
constexpr int LRU_SL = 64;
struct LruTask { int b, cg, s; };
__device__ __forceinline__ LruTask lru_task(int r) { LruTask t; if (r < 512) { t.b = r >> 4; t.cg = (r >> 2) & 3; t.s = r & 3; } else { const int q = r - 512; t.b = NB_CTX + (q >> 7); t.cg = (q >> 5) & 3; t.s = q & 31; } return t; }
__device__ __forceinline__ void lru_pass1(const Ctx& a, int tsk, int lane) {
    const int d = tsk & 1; const LruTask t = lru_task(tsk >> 1); const SeqInfo sq = seq_info(t.b);
    const bf16* G = (const bf16*)(a.ws + WS_G); f32x2* AB = (f32x2*)(a.ws + WS_U);
    const int ch = t.cg * 64 + lane;
    const bf16* gp = G + (size_t)(sq.row0 + t.s * LRU_SL) * 1024 + d * 512 + ch;
    float A = 1.f, B = 0.f;
#pragma unroll 1
    for (int g = 0; g < LRU_SL / 16; ++g) {
        bf16 la[16], bb[16];
#pragma unroll
        for (int i = 0; i < 16; ++i) { const int tt = d == 0 ? g * 16 + i : LRU_SL - 1 - (g * 16 + i); la[i] = gp[(size_t)tt * 1024]; bb[i] = gp[(size_t)tt * 1024 + 256]; }
#pragma unroll
        for (int i = 0; i < 16; ++i) { const float av = __builtin_amdgcn_exp2f(bf2f(la[i])); A *= av; B = av * B + bf2f(bb[i]); }
    }
    AB[((size_t)(t.b * 2 + d) * 32 + t.s) * 256 + ch] = (f32x2){A, B};
}
__device__ __forceinline__ void lru_pass2(const Ctx& a, int l, int r, int lane) {
    const LruTask t = lru_task(r); const SeqInfo sq = seq_info(t.b);
    const bf16* G = (const bf16*)(a.ws + WS_G); const bf16* P = (const bf16*)(a.ws + WS_P); const f32x2* AB = (const f32x2*)(a.ws + WS_U); bf16* MIX = (bf16*)(a.ws + WS_R1);
    const int ch = t.cg * 64 + lane, nsl = sq.T / LRU_SL;
    const float* st = a.in[I_SLRU];
    float h = sq.latent ? st[(((size_t)sq.bl * 2 + l) * 2 + 0) * 256 + ch] : 0.f;
    for (int s2 = 0; s2 < t.s; ++s2) { const f32x2 ab = AB[((size_t)(t.b * 2 + 0) * 32 + s2) * 256 + ch]; h = ab.x * h + ab.y; }
    float hf[LRU_SL];
    const bf16* gp = G + (size_t)(sq.row0 + t.s * LRU_SL) * 1024 + ch;
#pragma unroll
    for (int g = 0; g < LRU_SL / 16; ++g) {
        bf16 la[16], bb[16];
#pragma unroll
        for (int i = 0; i < 16; ++i) { la[i] = gp[(size_t)(g * 16 + i) * 1024]; bb[i] = gp[(size_t)(g * 16 + i) * 1024 + 256]; }
#pragma unroll
        for (int i = 0; i < 16; ++i) { h = __builtin_amdgcn_exp2f(bf2f(la[i])) * h + bf2f(bb[i]); hf[g * 16 + i] = h; }
    }
    if (!sq.latent && t.s == nsl - 1) a.out[OUT_LRU + (((size_t)sq.bl * 2 + l) * 2 + 0) * 256 + ch] = h;
    h = sq.latent ? st[(((size_t)sq.bl * 2 + l) * 2 + 1) * 256 + ch] : 0.f;
    for (int s2 = nsl - 1; s2 > t.s; --s2) { const f32x2 ab = AB[((size_t)(t.b * 2 + 1) * 32 + s2) * 256 + ch]; h = ab.x * h + ab.y; }
    const bf16* pp = P + (size_t)(sq.row0 + t.s * LRU_SL) * PP + C_GB + ch;
    bf16* mp = MIX + (size_t)(sq.row0 + t.s * LRU_SL) * D + 512 + ch;
#pragma unroll
    for (int g = LRU_SL / 16 - 1; g >= 0; --g) {
        bf16 la[16], bb[16], gb[16];
#pragma unroll
        for (int i = 0; i < 16; ++i) { const int tt = g * 16 + 15 - i; la[i] = gp[(size_t)tt * 1024 + 512]; bb[i] = gp[(size_t)tt * 1024 + 768]; gb[i] = pp[(size_t)tt * PP]; }
#pragma unroll
        for (int i = 0; i < 16; ++i) { const int tt = g * 16 + 15 - i; h = __builtin_amdgcn_exp2f(bf2f(la[i])) * h + bf2f(bb[i]);
            mp[(size_t)tt * D] = f2bf((hf[tt] + h) * gelu_tanh(bf2f(gb[i]))); }
    }
    if (!sq.latent && t.s == 0) a.out[OUT_LRU + (((size_t)sq.bl * 2 + l) * 2 + 1) * 256 + ch] = h;
}

constexpr int NU_RL = 64, NU_HL = 32, NU_RC = 256, NU_HC = 128, NU_L1 = 256, NU_ALL = NU_RL + NU_HL + NU_RC + NU_HC + NU_L1;
__device__ __forceinline__ Combo rwkv_combo(int i) { Combo c; c.d = i & 1; c.h = (i >> 1) & 7; c.b = i >> 4; return c; }
__device__ __forceinline__ Combo hgrn_combo(int i) { Combo c; c.d = i & 1; c.h = (i >> 1) & 3; c.b = i >> 3; return c; }
__device__ __forceinline__ void phase_scans(const Ctx& a, LAS unsigned char* lds, volatile LAS unsigned* MISC, int l, int rep, int tid, int wave, int lane) {
    unsigned* head = (unsigned*)(a.ws + WS_CTL) + CW_QUEUE + 64 * (l * 4 + rep);
    for (;;) {
        __syncthreads();
        if (tid == 0) MISC[0] = __hip_atomic_fetch_add(head, 1u, RLX_AGENT);
        __syncthreads();
        int u = (int)MISC[0];
        if (u >= NU_ALL) break;
        if (u < NU_RL) { const Combo c = rwkv_combo(512 + u); scan_unit<0, 1, 8>(a, lds, l, c, c, 0, tid, wave, lane); continue; } u -= NU_RL;
        if (u < NU_HL) { const Combo c = hgrn_combo(256 + u); scan_unit<1, 1, 8>(a, lds, l, c, c, 0, tid, wave, lane); continue; } u -= NU_HL;
        if (u < NU_RC) { scan_unit<0, 2, 8>(a, lds, l, rwkv_combo(2 * u), rwkv_combo(2 * u + 1), 0, tid, wave, lane); continue; } u -= NU_RC;
        if (u < NU_HC) { scan_unit<1, 2, 8>(a, lds, l, hgrn_combo(2 * u), hgrn_combo(2 * u + 1), 0, tid, wave, lane); continue; } u -= NU_HC;
        lru_pass1(a, u * 8 + wave, lane);
    }
}

__device__ __forceinline__ void phase_post(const Ctx& a, int l, int gw, int NGW, int lane) {
    const bf16* P = (const bf16*)(a.ws + WS_P); const bf16* L = (const bf16*)(a.ws + WS_L);
    const bf16* ORf = (const bf16*)(a.ws + WS_OR); const bf16* ORb = ORf + (size_t)MTOK * 512;
    const bf16* OHf = (const bf16*)(a.ws + WS_OH); const bf16* OHb = OHf + (size_t)MTOK * 256;
    bf16* MIX = (bf16*)(a.ws + WS_R1);
    if (gw < 1024) lru_pass2(a, l, gw, lane);
    const int sub = lane >> 4, li = lane & 15;
    const float* p_rk = a.in[I_RK] + l * 512; const float* p_lnw = a.in[I_LNW] + l * 512; const float* p_lnb = a.in[I_LNB] + l * 512; const float* p_hng = a.in[I_HNG] + l * 256;
    for (int r = gw; r < MTOK; r += NGW) {
        const size_t row = (size_t)r;
#pragma unroll
        for (int pass = 0; pass < 2; ++pass) {
            const int h = 4 * pass + sub, c0 = h * 64 + 4 * li;
            const v2u of = *(const v2u*)(ORf + row * 512 + c0), ob = *(const v2u*)(ORb + row * 512 + c0);
            const v2u rr = *(const v2u*)(P + row * PP + C_R + c0), kk = *(const v2u*)(P + row * PP + C_K + c0), vv = *(const v2u*)(P + row * PP + C_V + c0);
            const v2u gg = *(const v2u*)(L + row * NLORA + 2048 + c0);
            f32x4 o = {bf_lo(of.x) + bf_lo(ob.x), bf_hi(of.x) + bf_hi(ob.x), bf_lo(of.y) + bf_lo(ob.y), bf_hi(of.y) + bf_hi(ob.y)};
            const f32x4 r4 = {bf_lo(rr.x), bf_hi(rr.x), bf_lo(rr.y), bf_hi(rr.y)}, k4 = {bf_lo(kk.x), bf_hi(kk.x), bf_lo(kk.y), bf_hi(kk.y)};
            const f32x4 v4 = {bf_lo(vv.x), bf_hi(vv.x), bf_lo(vv.y), bf_hi(vv.y)}, g4 = {bf_lo(gg.x), bf_hi(gg.x), bf_lo(gg.y), bf_hi(gg.y)};
            const f32x4 rk = *(const f32x4*)(p_rk + c0), lw = *(const f32x4*)(p_lnw + c0), lb = *(const f32x4*)(p_lnb + c0);
            const float mu = rowsum16((o.x + o.y) + (o.z + o.w)) * (1.0f / 64.0f);
            o = o - mu;
            const float var = rowsum16((o.x * o.x + o.y * o.y) + (o.z * o.z + o.w * o.w)) * (1.0f / 64.0f);
            const float rs = rsqrtf(var + 64e-5f);
            const float bon = rowsum16((r4.x * k4.x * rk.x + r4.y * k4.y * rk.y) + (r4.z * k4.z * rk.z + r4.w * k4.w * rk.w));
            const f32x4 y = (o * rs * lw + lb + v4 * bon) * g4;
            v2u w; w.x = cvt_pk_bf16(y.x, y.y); w.y = cvt_pk_bf16(y.z, y.w);
            *(v2u*)(MIX + row * D + c0) = w;
        }
        {
            const int c0 = sub * 64 + 4 * li;
            const v2u of = *(const v2u*)(OHf + row * 256 + c0), ob = *(const v2u*)(OHb + row * 256 + c0);
            const v2u gg = *(const v2u*)(P + row * PP + C_OG + c0);
            const f32x4 o = {bf_lo(of.x) + bf_lo(ob.x), bf_hi(of.x) + bf_hi(ob.x), bf_lo(of.y) + bf_lo(ob.y), bf_hi(of.y) + bf_hi(ob.y)};
            const f32x4 g4 = {bf_lo(gg.x), bf_hi(gg.x), bf_lo(gg.y), bf_hi(gg.y)};
            const f32x4 ng = *(const f32x4*)(p_hng + c0);
            const float ms = rowsum16((o.x * o.x + o.y * o.y) + (o.z * o.z + o.w * o.w)) * (1.0f / 64.0f);
            const float rs = rsqrtf(ms + 1e-6f);
            f32x4 y;
#pragma unroll
            for (int j = 0; j < 4; ++j) y[j] = o[j] * rs * ng[j] * (g4[j] * fsigmoid(g4[j]));
            v2u w; w.x = cvt_pk_bf16(y.x, y.y); w.y = cvt_pk_bf16(y.z, y.w);
            *(v2u*)(MIX + row * D + 768 + c0) = w;
        }
    }
}
__device__ __forceinline__ void phase_ffn_act(const Ctx& a, int l, int gtid, int NGT) {
    const bf16* GU = (const bf16*)(a.ws + WS_GU); bf16* ACT = (bf16*)(a.ws + WS_ACT);
    const float* cw = a.in[I_FCW] + l * 3 * DFF; const float* cb = a.in[I_FCB] + l * DFF;
    for (int it = gtid; it < (MTOK / 4) * (DFF / 8); it += NGT) {
        const int r0 = (it / (DFF / 8)) * 4, c0 = (it % (DFF / 8)) * 8;
        const int tt = r0 < MCTX ? (r0 & 255) : (r0 & 63), Ts = r0 < MCTX ? 256 : 64;
        const int gc = (c0 >> 7) * 256 + (c0 & 127);
        v4u gx[6], ux[4];
#pragma unroll
        for (int k = 0; k < 6; ++k) { const int t2 = tt + k - 1; gx[k] = (v4u){0u, 0u, 0u, 0u}; if (t2 >= 0 && t2 < Ts) gx[k] = *(const v4u*)(GU + (size_t)(r0 + k - 1) * NGU + gc); }
#pragma unroll
        for (int k = 0; k < 4; ++k) ux[k] = *(const v4u*)(GU + (size_t)(r0 + k) * NGU + gc + 128);
        float w0[8], w1[8], w2[8], bs[8];
#pragma unroll
        for (int j = 0; j < 8; ++j) { w0[j] = cw[c0 + j]; w1[j] = cw[DFF + c0 + j]; w2[j] = cw[2 * DFF + c0 + j]; bs[j] = cb[c0 + j]; }
#pragma unroll
        for (int k = 0; k < 4; ++k) {
            const v4u xa = gx[k], xb = gx[k + 1], xc = gx[k + 2], up = ux[k];
            const float va[8] = {bf_lo(xa.x), bf_hi(xa.x), bf_lo(xa.y), bf_hi(xa.y), bf_lo(xa.z), bf_hi(xa.z), bf_lo(xa.w), bf_hi(xa.w)};
            const float vb[8] = {bf_lo(xb.x), bf_hi(xb.x), bf_lo(xb.y), bf_hi(xb.y), bf_lo(xb.z), bf_hi(xb.z), bf_lo(xb.w), bf_hi(xb.w)};
            const float vc[8] = {bf_lo(xc.x), bf_hi(xc.x), bf_lo(xc.y), bf_hi(xc.y), bf_lo(xc.z), bf_hi(xc.z), bf_lo(xc.w), bf_hi(xc.w)};
            const float uv[8] = {bf_lo(up.x), bf_hi(up.x), bf_lo(up.y), bf_hi(up.y), bf_lo(up.z), bf_hi(up.z), bf_lo(up.w), bf_hi(up.w)};
            float acc[8];
#pragma unroll
            for (int j = 0; j < 8; ++j) { const float g = bs[j] + w0[j] * va[j] + w1[j] * vb[j] + w2[j] * vc[j]; acc[j] = g * fsigmoid(g) * uv[j]; }
            v4u o; o.x = cvt_pk_bf16(acc[0], acc[1]); o.y = cvt_pk_bf16(acc[2], acc[3]); o.z = cvt_pk_bf16(acc[4], acc[5]); o.w = cvt_pk_bf16(acc[6], acc[7]);
            *(v4u*)(ACT + (size_t)(r0 + k) * DFF + c0) = o;
        }
    }
}

#ifndef REP_K
#define REP_K -2
#define REP_N 0
#endif
constexpr int PHL = 10, PHLX = PHL + REP_N, N_PHASES = 1 + 2 * PHLX + 1;
__global__ void __launch_bounds__(NTHR, 2) trunk_fwd(Args args) {
    extern __shared__ __attribute__((aligned(16))) unsigned char lds_raw[];
    LAS unsigned char* lds = (LAS unsigned char*)lds_raw;
    volatile LAS unsigned* MISC = (volatile LAS unsigned*)(lds + MISC_OFF);
    const int G = gridDim.x, bid = blockIdx.x, NGW = G * NWAVES, NGT = G * NTHR;
    { const int tid = threadIdx.x;
    for (int u = tid; u < (LDS_BYTES - LDSCTL_OFF) / 4; u += NTHR) ((LAS unsigned*)(lds + LDSCTL_OFF))[u] = 0u;
    __syncthreads();
    if (tid == 0) {
#pragma unroll
        for (int i = 0; i < 38; ++i) ((LAS unsigned long long*)(lds + PTBL_OFF))[i] = (unsigned long long)args.in[i];
        LAS unsigned long long* jd = (LAS unsigned long long*)(lds + JDESC_OFF);
        unsigned char* w = args.ws; float* o = args.out;
#pragma unroll
        for (int l = 0; l < 2; ++l) {
            const unsigned long long modl = (unsigned long long)(w + WS_MOD) + (unsigned long long)l * NSLOT * 6144 * 4;
#pragma unroll
            for (int k = 0; k < PHL; ++k) {
                LAS unsigned long long* d = jd + (1 + PHL * l + k) * 12;
                unsigned long long A = 0, Bt = 0, O = 0, f0 = 0, f1 = 0, f2 = 0, U = 0, xo = 0; unsigned N = 0, K = 0, lda = 0, kind = 0xffu, ldc = 0, rowperm = 0;
                if (k == 1) { A = (unsigned long long)(w + WS_R1); Bt = (unsigned long long)(w + WS_W + W_IN); N = NPROJ; K = D; lda = D; kind = pg8::K_PROJ; ldc = PP; O = (unsigned long long)(w + WS_P); }
                if (k == 2) { A = (unsigned long long)(w + WS_P) + C_LORA * 2; Bt = (unsigned long long)(w + WS_W + W_LORA); N = NLORA; K = KLORA; lda = PP; kind = pg8::K_LORA; ldc = NLORA; O = (unsigned long long)(w + WS_L);
                    f0 = (unsigned long long)(args.in[I_W0] + l * 1024); f1 = (unsigned long long)(args.in[I_A0] + l * 1024); }
                if (k == 3) { A = (unsigned long long)(w + WS_U); Bt = (unsigned long long)(w + WS_W + W_GATE); N = NGATE; K = KGATE; lda = KGATE; kind = pg8::K_GATES; ldc = 1024; O = (unsigned long long)(w + WS_G);
                    f0 = (unsigned long long)(args.in[I_LBA] + l * 512); f1 = (unsigned long long)(args.in[I_LBX] + l * 512); f2 = (unsigned long long)(w + WS_SP) + (unsigned long long)l * 512 * 4; U = (unsigned long long)(w + WS_U); }
                if (k == 6) { A = (unsigned long long)(w + WS_R1); Bt = (unsigned long long)(w + WS_W + W_OUT); N = D; K = D; lda = D; kind = pg8::K_RESID;
                    f0 = l == 0 ? (unsigned long long)args.in[I_XP] : (unsigned long long)o; f1 = l == 0 ? (unsigned long long)args.in[I_XS] : (unsigned long long)(o + (size_t)MCTX * D); f2 = modl + 2 * D * 4; xo = (unsigned long long)o; }
                if (k == 8) { A = (unsigned long long)(w + WS_R1); Bt = (unsigned long long)(w + WS_W + W_GU); N = NGU; K = D; lda = D; kind = pg8::K_GUACT; ldc = DFF; O = (unsigned long long)(w + WS_ACT); rowperm = 1;
                    f0 = (unsigned long long)(args.in[I_FCW] + l * 3 * DFF); f1 = (unsigned long long)(args.in[I_FCB] + l * DFF); }
                if (k == 9) { A = (unsigned long long)(w + WS_ACT); Bt = (unsigned long long)(w + WS_W + W_DOWN); N = D; K = DFF; lda = DFF; kind = pg8::K_RESID;
                    f0 = (unsigned long long)o; f1 = (unsigned long long)(o + (size_t)MCTX * D); f2 = modl + 5 * D * 4; xo = (unsigned long long)o; }
                d[0] = A; d[1] = Bt; d[2] = O; d[3] = f0; d[4] = f1; d[5] = f2; d[6] = U; d[7] = xo;
                d[8] = ((unsigned long long)K << 32) | N; d[9] = ((unsigned long long)kind << 32) | lda; d[10] = ((unsigned long long)rowperm << 32) | ldc; d[11] = 0;
            }
        }
        jd[9] = 0xffull << 32; jd[(1 + 2 * PHL) * 12 + 9] = 0xffull << 32;
    }
    __syncthreads(); }
    LAS unsigned long long* ptbl = (LAS unsigned long long*)(lds + PTBL_OFF);
    float* const out0 = args.out; unsigned char* const ws0 = args.ws;
    const int lo = args.ph_lo, hi = args.ph_hi;
    XcdBarrier bar; bar.bar = (unsigned*)(ws0 + WS_CTL) + CW_BAR; bar.x = 0; bar.st = nullptr;
    if (hi - lo > 1) bar = xcd_barrier_post((unsigned*)(ws0 + WS_CTL) + CW_BAR, MISC + 8);
#pragma unroll 1
    for (int ph = lo; ph < hi; ++ph) {
        int tid_ = threadIdx.x; asm volatile("" : "+v"(tid_));
        const int tid = tid_, lane = tid & 63, wave = __builtin_amdgcn_readfirstlane(tid >> 6), gw = bid * NWAVES + wave, gtid = bid * NTHR + tid;
        unsigned long long out_u = (unsigned long long)out0, ws_u = (unsigned long long)ws0; asm volatile("" : "+s"(out_u), "+s"(ws_u));
        float* out_ = (float*)(GAS float*)out_u; unsigned char* ws = (unsigned char*)(GAS unsigned char*)ws_u;
        const Ctx cx{{ptbl}, out_, ws};
        int l = 0, k = -1;
        int rep = 0;
        if (ph == N_PHASES - 1) k = 100; else if (ph > 0) { l = (ph - 1) / PHLX; k = (ph - 1) % PHLX;
            if (REP_N > 0 && k > REP_K) { if (k <= REP_K + REP_N) { rep = k - REP_K; k = REP_K; } else k -= REP_N; } }
        {
            const LAS unsigned long long* d = (const LAS unsigned long long*)(lds + JDESC_OFF) + (k == -1 ? 0 : (k == 100 ? 1 + 2 * PHL : 1 + PHL * l + k)) * 12;
            unsigned long long q[11];
#pragma unroll
            for (int i = 0; i < 11; ++i) { const unsigned long long v = d[i];
                q[i] = ((unsigned long long)__builtin_amdgcn_readfirstlane((unsigned)(v >> 32)) << 32) | (unsigned)__builtin_amdgcn_readfirstlane((unsigned)v); }
            const unsigned kind = (unsigned)(q[9] >> 32);
            if (kind != 0xffu) {
                pg8::Gemm g; pg8::EpiAny E;
                g.A = (const bf16*)(const GAS bf16*)q[0]; g.Bt = (const bf16*)(const GAS bf16*)q[1]; g.M = MTOK; g.N = (int)(unsigned)q[8]; g.K = (int)(q[8] >> 32); g.lda = (int)(unsigned)q[9]; g.rowperm = (int)(q[10] >> 32);
                E.kind = (int)kind; E.ldc = (int)(unsigned)q[10]; E.O = (bf16*)(GAS bf16*)q[2]; E.f0 = (const float*)(const GAS float*)q[3]; E.f1 = (const float*)(const GAS float*)q[4];
                E.f2 = (const float*)(const GAS float*)q[5]; E.U = (const bf16*)(const GAS bf16*)q[6]; E.xout = (float*)(GAS float*)q[7];
                pg8::StaticOrder S; S.init(MTOK, g.N, G, bid);
                pg8::gemm_phase<pg8::EpiAny, pg8::StaticOrder, true, true>(lds + RING_OFF, g, S, E);
            }
        }
        if (k == -1) { mod_partials(cx, lds, bid, G, tid); convert_weights(cx, 0, lds, gw, NGW, wave, lane, gtid, NGT); }
        else if (k == 0) { if (l == 0) mod_finalize(cx, gtid, NGT); else convert_weights(cx, l, lds, gw, NGW, wave, lane, gtid, NGT);
            phase_norm(cx, lds, l, 0, l == 0, l == 0, bid, G, tid, wave, lane); }
        else if (k == 2) phase_lru_conv(cx, l, gtid, NGT);
        else if (k == 4) phase_scans(cx, lds, MISC, l, rep, tid, wave, lane);
        else if (k == 5) phase_post(cx, l, gw, NGW, lane);
        else if (k == 7) phase_norm(cx, lds, l, 1, false, false, bid, G, tid, wave, lane);
        else if (k == 100) phase_final_norm(cx, gw, NGW, lane);
        if (ph + 1 < hi) xcd_barrier(bar);
    }
}

#ifndef MK_PER_PHASE
#define MK_PER_PHASE 0
#endif
extern "C" void kernel_launch(void* const* d_in, const int* in_sizes, int n_in, void* d_out, int out_size, void* d_ws, size_t ws_size, hipStream_t stream) {
    static int grid = 0;
    if (grid == 0) {
        if (n_in != 38 || (size_t)out_size != OUT_END || ws_size < WS_END) { fprintf(stderr, "kernel_launch: unexpected shapes (n_in %d, out %d, ws %zu); nothing launched\n", n_in, out_size, ws_size); grid = -1; return; }
        int dev = 0, cus = 0, per_cu = 0;
        if (hipGetDevice(&dev) != hipSuccess || hipDeviceGetAttribute(&cus, hipDeviceAttributeMultiprocessorCount, dev) != hipSuccess) { grid = -1; return; }
        if (hipFuncSetAttribute((const void*)trunk_fwd, hipFuncAttributeMaxDynamicSharedMemorySize, LDS_BYTES) != hipSuccess) { fprintf(stderr, "kernel_launch: hipFuncSetAttribute failed\n"); grid = -1; return; }
        if (hipOccupancyMaxActiveBlocksPerMultiprocessor(&per_cu, (const void*)trunk_fwd, NTHR, LDS_BYTES) != hipSuccess || per_cu < 1) { fprintf(stderr, "kernel_launch: occupancy query says %d\n", per_cu); (void)hipGetLastError(); per_cu = 1; }
        grid = cus;
    }
    if (grid < 0) return;
    (void)hipMemsetAsync((char*)d_ws + WS_CTL, 0, CTL_ZERO_BYTES, stream);
    Args a{};
    for (int i = 0; i < 38; ++i) a.in[i] = (const float*)d_in[i];
    a.out = (float*)d_out; a.ws = (unsigned char*)d_ws;
#if MK_PER_PHASE
    for (int p = 0; p < N_PHASES; ++p) { a.ph_lo = p; a.ph_hi = p + 1; hipLaunchKernelGGL(trunk_fwd, dim3(grid), dim3(NTHR), LDS_BYTES, stream, a); }
#else
    a.ph_lo = 0; a.ph_hi = N_PHASES;
    hipLaunchKernelGGL(trunk_fwd, dim3(grid), dim3(NTHR), LDS_BYTES, stream, a);
#endif
}
```

```cpp
#include <hip/hip_runtime.h>
#include <cstdio>
#include <cstdint>
namespace pg8 {
#define PG8_LAS __attribute__((address_space(3)))
typedef unsigned short bf16_t;
typedef short bf16x8 __attribute__((ext_vector_type(8)));
typedef float f32x4 __attribute__((ext_vector_type(4)));
typedef unsigned u32x4 __attribute__((ext_vector_type(4)));
constexpr int BM = 256, BK = 64, HALF = 128, HTB = HALF * BK * 2  , STAGE_BYTES = 8 * HTB, NXCD = 8, WGM = 8;

__host__ __device__ __forceinline__ int lds_byte(int r, int c) { const int st = (r >> 4) * 2 + (c >> 5), rr = r & 15, cc = c & 31, ob = rr * 64 + cc * 2; return st * 1024 + (ob ^ (((ob >> 9) & 1) << 5)); }
__host__ __device__ __forceinline__ void stage_rc(int b, int& R, int& C) { const int st = b / 1024, sb = b % 1024, swz = sb ^ (((sb >> 9) & 1) << 5); R = (st >> 1) * 16 + swz / 64; C = (st & 1) * 32 + (swz % 64) / 2; }
__host__ __device__ __forceinline__ int perm32(int rho) { const int n = rho >> 4, i = rho & 15; return 8 * (i >> 2) + 4 * n + (i & 3); }

struct Unit { int pm, pn; };
struct Gemm { const bf16_t* A; const bf16_t* Bt; int M, N, K, lda, rowperm, ks_sh, ks_msk; };

struct StaticOrder {
    int nM, nN, nwg, G, c;
    __host__ __device__ void init(int M, int N, int G_, int c_) { nM = M / BM; nN = N / BM; nwg = nM * nN; G = G_; c = c_; }
    __host__ __device__ bool next(int i, Unit& u) const {
        const long L = (long)i * G + c; if (L >= nwg) return false;
        int wgid = (int)L; { const int q = nwg / NXCD, r = nwg % NXCD, xcd = wgid % NXCD, off = wgid / NXCD; wgid = (xcd < r ? xcd * (q + 1) : r * (q + 1) + (xcd - r) * q) + off; }
        const int nig = WGM * nN, gid = wgid / nig, fm = gid * WGM, gsz = (nM - fm) < WGM ? (nM - fm) : WGM;
        u.pm = fm + ((wgid % nig) % gsz); u.pn = (wgid % nig) / gsz; return true;
    }
    __device__ __forceinline__ void a_ready(const Unit&) const {}
    __device__ __forceinline__ void done(const Unit&) const {}
};

__device__ __forceinline__ unsigned cvt_pk_bf16(float lo, float hi) { unsigned r; asm volatile("v_cvt_pk_bf16_f32 %0, %1, %2" : "=v"(r) : "v"(lo), "v"(hi)); return r; }
__device__ __forceinline__ float fsigmoid(float x) { return __builtin_amdgcn_rcpf(1.0f + __expf(-x)); }
__device__ __forceinline__ float ftanh(float x) { return 1.0f - 2.0f * __builtin_amdgcn_rcpf(1.0f + __expf(2.0f * x)); }
__device__ __forceinline__ float bf_lo(unsigned w) { return __uint_as_float(w << 16); }
__device__ __forceinline__ float bf_hi(unsigned w) { return __uint_as_float(w & 0xffff0000u); }

constexpr int PP = 3712;
enum EpiKind { K_PROJ = 0, K_LORA = 1, K_PLAIN = 2, K_GATES = 3, K_RESID = 4, K_GUACT = 5 };
constexpr int XCH_OFF = 131072 + 8192;
struct EpiAny {
    static constexpr bool AFTER_DRAIN = false;
    int kind, ldc; bf16_t* O; const float* f0; const float* f1; const float* f2; const bf16_t* U; float* xout;
    __device__ __forceinline__ bool perm() const { return kind != K_RESID; }
    __device__ __forceinline__ void operator()(const f32x4 (&acc)[2][2][4][2], const Unit& u, int wr, int wc, int fr, int fq, PG8_LAS unsigned char* lds) const {
        const int row0 = u.pm * BM + wr * 64 + fr;
        if (kind == K_GUACT) {
            const bool ctx = u.pm < 32;
            const int cb0 = u.pn * HALF + wc * 32 + 8 * fq;
            PG8_LAS float* xch = (PG8_LAS float*)(lds + XCH_OFF);
            if (fr == (wr == 0 ? 15 : 0)) {
#pragma unroll
                for (int n = 0; n < 2; ++n)
#pragma unroll
                    for (int j = 0; j < 4; ++j) xch[((wr * 4 + wc) * 4 + fq) * 8 + 4 * n + j] = wr == 0 ? acc[1][0][3][n][j] : acc[0][0][0][n][j];
            }
            asm volatile("s_waitcnt lgkmcnt(0)" ::: "memory"); __builtin_amdgcn_s_barrier(); asm volatile("" ::: "memory");
            const size_t tok0 = (size_t)u.pm * BM + 128 * wr + 8 * fr;
#pragma unroll
            for (int n = 0; n < 2; ++n) {
                const f32x4 w0 = *(const f32x4*)(f0 + cb0 + 4 * n), w1 = *(const f32x4*)(f0 + 2816 + cb0 + 4 * n), w2 = *(const f32x4*)(f0 + 2 * 2816 + cb0 + 4 * n), bs = *(const f32x4*)(f1 + cb0 + 4 * n);
                const f32x4 xo = *(const PG8_LAS f32x4*)(xch + (((1 - wr) * 4 + wc) * 4 + fq) * 8 + 4 * n);
                float res[8][4];
#pragma unroll
                for (int j = 0; j < 4; ++j) {
                    float g[8];
#pragma unroll
                    for (int i = 0; i < 8; ++i) g[i] = acc[i >> 2][0][i & 3][n][j];
                    float left = __builtin_bit_cast(float, __builtin_amdgcn_update_dpp(0, __builtin_bit_cast(int, g[7]), 0x111, 0xf, 0xf, true));
                    float right = __builtin_bit_cast(float, __builtin_amdgcn_update_dpp(0, __builtin_bit_cast(int, g[0]), 0x101, 0xf, 0xf, true));
                    if (ctx) { if (wr == 1 && fr == 0) left = xo[j]; if (wr == 0 && fr == 15) right = xo[j]; }
                    else { if ((fr & 7) == 0) left = 0.f; if ((fr & 7) == 7) right = 0.f; }
#pragma unroll
                    for (int i = 0; i < 8; ++i) { const float gm = i == 0 ? left : g[i - 1], gp_ = i == 7 ? right : g[i + 1];
                        const float c = bs[j] + w0[j] * gm + w1[j] * g[i] + w2[j] * gp_;
                        res[i][j] = c * fsigmoid(c) * acc[i >> 2][1][i & 3][n][j]; }
                }
#pragma unroll
                for (int i = 0; i < 8; ++i) { uint2 w; w.x = cvt_pk_bf16(res[i][0], res[i][1]); w.y = cvt_pk_bf16(res[i][2], res[i][3]);
                    *(uint2*)(O + (tok0 + i) * 2816 + cb0 + 4 * n) = w; }
            }
        } else if (kind == K_RESID) {
            const int col0 = u.pn * BM + wc * 32 + 4 * fq;
            const int slot = u.pm < 32 ? 0 : 1 + ((u.pm - 32) >> 3);
            const float* src = u.pm < 32 ? f0 : f1 - (size_t)8192 * 1024;
            const float* gp = f2 + (size_t)slot * 6144;
#pragma unroll
            for (int bj = 0; bj < 2; ++bj)
#pragma unroll
                for (int n = 0; n < 2; ++n) { const f32x4 gv = *(const f32x4*)(gp + col0 + bj * HALF + n * 16);
                    f32x4 xs[2][4];
#pragma unroll
                    for (int ai = 0; ai < 2; ++ai)
#pragma unroll
                        for (int m = 0; m < 4; ++m) xs[ai][m] = *(const f32x4*)(src + (size_t)(row0 + ai * HALF + m * 16) * 1024 + col0 + bj * HALF + n * 16);
                    asm volatile("" ::: "memory");
#pragma unroll
                    for (int ai = 0; ai < 2; ++ai)
#pragma unroll
                        for (int m = 0; m < 4; ++m) *(f32x4*)(xout + (size_t)(row0 + ai * HALF + m * 16) * 1024 + col0 + bj * HALF + n * 16) = xs[ai][m] + gv * acc[ai][bj][m][n];
                    asm volatile("" ::: "memory"); }
        } else if (kind == K_GATES) {
            const int d = u.pn >> 1, ch0 = (u.pn & 1) * HALF + wc * 32 + 8 * fq;
#pragma unroll
            for (int n = 0; n < 2; ++n) {
                const f32x4 bav = *(const f32x4*)(f0 + d * 256 + ch0 + 4 * n), bxv = *(const f32x4*)(f1 + d * 256 + ch0 + 4 * n), spv = *(const f32x4*)(f2 + d * 256 + ch0 + 4 * n);
#pragma unroll
                for (int ai = 0; ai < 2; ++ai)
#pragma unroll
                    for (int m = 0; m < 4; ++m) {
                        const size_t row = (size_t)(row0 + ai * HALF + m * 16);
                        const uint2 uu = *(const uint2*)(U + row * 256 + ch0 + 4 * n);
                        const float uv[4] = {bf_lo(uu.x), bf_hi(uu.x), bf_lo(uu.y), bf_hi(uu.y)};
                        float la2[4], bb[4];
#pragma unroll
                        for (int j = 0; j < 4; ++j) {
                            const float rg = fsigmoid(acc[ai][0][m][n][j] + bav[j]), ig = fsigmoid(acc[ai][1][m][n][j] + bxv[j]);
                            const float la = -8.0f * rg * spv[j];
                            la2[j] = la * 1.44269504089f; bb[j] = sqrtf(-expm1f(2.0f * la)) * ig * uv[j]; }
                        uint2 w0; w0.x = cvt_pk_bf16(la2[0], la2[1]); w0.y = cvt_pk_bf16(la2[2], la2[3]);
                        uint2 w1; w1.x = cvt_pk_bf16(bb[0], bb[1]); w1.y = cvt_pk_bf16(bb[2], bb[3]);
                        *(uint2*)(O + row * 1024 + d * 512 + ch0 + 4 * n) = w0;
                        *(uint2*)(O + row * 1024 + d * 512 + 256 + ch0 + 4 * n) = w1;
                        asm volatile("" ::: "memory");
                    }
            }
        } else {
            const int col0 = u.pn * BM + wc * 32 + 8 * fq;
#pragma unroll
            for (int bj = 0; bj < 2; ++bj) {
                int act = 0; float sc = 1.0f; f32x4 b0 = (f32x4){0.f, 0.f, 0.f, 0.f}, b1 = b0;
                if (kind == K_PROJ) { if (u.pn == 14 && bj == 1) continue; act = (u.pn == 6 && bj == 0) ? 1 : ((u.pn == 7 && bj == 0) ? 2 : 0); }
                if (kind == K_LORA) { const int grp = u.pn >> 1, cc = (col0 + bj * HALF) & 1023;
                    if (grp < 4) { const float* bp = (grp < 2 ? f0 : f1) + cc; b0 = *(const f32x4*)bp; b1 = *(const f32x4*)(bp + 4); act = 2; sc = grp < 2 ? 0.60653065971f : 1.0f; } }
#pragma unroll
                for (int ai = 0; ai < 2; ++ai)
#pragma unroll
                    for (int m = 0; m < 4; ++m) {
                        f32x4 v0 = acc[ai][bj][m][0] + b0, v1 = acc[ai][bj][m][1] + b1;
                        if (act == 1) {
#pragma unroll
                            for (int j = 0; j < 4; ++j) { v0[j] = ftanh(v0[j]); v1[j] = ftanh(v1[j]); } }
                        if (act == 2) {
#pragma unroll
                            for (int j = 0; j < 4; ++j) { v0[j] = fsigmoid(v0[j]) * sc; v1[j] = fsigmoid(v1[j]) * sc; } }
                        u32x4 w; w.x = cvt_pk_bf16(v0[0], v0[1]); w.y = cvt_pk_bf16(v0[2], v0[3]); w.z = cvt_pk_bf16(v1[0], v1[1]); w.w = cvt_pk_bf16(v1[2], v1[3]);
                        *(u32x4*)(O + (size_t)(row0 + ai * HALF + m * 16) * ldc + col0 + bj * HALF) = w;
                    }
            }
        }
    }
};
template <class Epi, class Sched, bool ALIGN_EPI = false, bool SP2 = false>
__device__ __forceinline__ void gemm_phase(PG8_LAS unsigned char* lds, const Gemm g, const Sched& S, const Epi& E) {
    int tid_ = threadIdx.x; asm volatile("" : "+v"(tid_));
    const int tid = tid_, wid = __builtin_amdgcn_readfirstlane(tid >> 6), lane = tid & 63, wr = wid >> 2, wc = wid & 3, fr = lane & 15, fq = lane >> 4;
    const int K = g.K, nt = K / BK;
    unsigned voffA[2], voffB[2];
    {
        const int b0 = tid * 16, st = b0 >> 10, sb = b0 & 1023, swz = sb ^ (((sb >> 9) & 1) << 5);
        const int R0 = (st >> 1) * 16 + (swz >> 6), C0 = (st & 1) * 32 + ((swz & 63) >> 1);
        const int Rb = E.perm() ? ((R0 & ~31) + perm32(R0 & 31)) : R0;
        const int Rt = g.rowperm ? (8 * (R0 & 15) + ((R0 >> 4) & 3)) : R0;
        voffA[0] = (unsigned)(Rt * g.lda + C0) * 2u; voffA[1] = voffA[0] + (unsigned)((g.rowperm ? 128 : 64) * g.lda) * 2u;
        voffB[0] = (unsigned)(Rb * K + C0) * 2u; voffB[1] = voffB[0] + (unsigned)(64 * K) * 2u;
    }
    const size_t kstep = (size_t)(BK * 2);
    const size_t hsA = (size_t)(g.rowperm ? 4 : HALF) * g.lda * 2, hsB = (size_t)HALF * K * 2;
    const size_t tsA = (size_t)BM * g.lda * 2, tsB = 2 * hsB;
    const unsigned ldsw = (unsigned)wid * 1024u;
    const int aoff = lds_byte(wr * 64 + fr, fq * 8), boff = lds_byte(wc * 32 + fr, fq * 8);
#define PG8_SA(b, h) (((b) * 2 + (h)) * HTB)
#define PG8_SB(b, h) ((4 + (b) * 2 + (h)) * HTB)
#define PG8_STAGE(bufoff, gbase, voff) do { _Pragma("unroll") for (int _i = 0; _i < 2; ++_i) \
        __builtin_amdgcn_global_load_lds((const unsigned*)((const char*)(gbase) + (voff)[_i]), (PG8_LAS unsigned*)(lds + (bufoff) + ldsw + _i * 8192), 16, 0, 0); } while (0)
#define PG8_LDA(dst, b, h) do { _Pragma("unroll") for (int m = 0; m < 4; ++m) _Pragma("unroll") for (int k = 0; k < 2; ++k) dst[m][k] = *(const PG8_LAS bf16x8*)(lds + PG8_SA(b, h) + aoff + m * 2048 + k * 1024); } while (0)
#define PG8_LDB(dst, b, h) do { _Pragma("unroll") for (int n = 0; n < 2; ++n) _Pragma("unroll") for (int k = 0; k < 2; ++k) dst[n][k] = *(const PG8_LAS bf16x8*)(lds + PG8_SB(b, h) + boff + n * 2048 + k * 1024); } while (0)
#define PG8_MMA(ai, bj, At, Bt) do { __builtin_amdgcn_s_setprio(1); _Pragma("unroll") for (int m = 0; m < 4; ++m) _Pragma("unroll") for (int n = 0; n < 2; ++n) _Pragma("unroll") for (int k = 0; k < 2; ++k) \
        acc[ai][bj][m][n] = __builtin_amdgcn_mfma_f32_16x16x32_bf16(Bt[n][k], At[m][k], acc[ai][bj][m][n], 0, 0, 0); __builtin_amdgcn_s_setprio(0); } while (0)
#define PG8_WAIT_V(n) asm volatile("s_waitcnt vmcnt(" #n ")" ::: "memory")
#define PG8_WAIT_L(n) asm volatile("s_waitcnt lgkmcnt(" #n ")" ::: "memory")
#define PG8_BAR __builtin_amdgcn_s_barrier()
#define PG8_SCHED __builtin_amdgcn_sched_barrier(0)
    Unit cur, nxt; int ui = 0;
    if (!S.next(0, cur)) return;
    f32x4 acc[2][2][4][2];
#pragma unroll
    for (int a = 0; a < 2; ++a)
#pragma unroll
        for (int b = 0; b < 2; ++b)
#pragma unroll
            for (int m = 0; m < 4; ++m)
#pragma unroll
                for (int n = 0; n < 2; ++n) acc[a][b][m][n] = (f32x4){0.f, 0.f, 0.f, 0.f};
    bf16x8 At[4][2], B0[2][2], B1[2][2];
    const char* cA = (const char*)g.A + (size_t)cur.pm * tsA + (size_t)((cur.pn >> g.ks_sh) & g.ks_msk) * 256;     const char* cB = (const char*)g.Bt + (size_t)cur.pn * tsB;
    S.a_ready(cur);
    if constexpr (SP2) {
        PG8_STAGE(PG8_SB(0, 0), cB, voffB); PG8_STAGE(PG8_SB(0, 1), cB + hsB, voffB); PG8_STAGE(PG8_SA(0, 0), cA, voffA); PG8_STAGE(PG8_SA(0, 1), cA + hsA, voffA);
        if (wr == 1) PG8_BAR;
        PG8_WAIT_V(2); PG8_BAR;
        PG8_STAGE(PG8_SB(1, 0), cB + kstep, voffB); PG8_STAGE(PG8_SA(1, 0), cA + kstep, voffA); PG8_STAGE(PG8_SB(1, 1), cB + hsB + kstep, voffB);
        PG8_WAIT_V(6); PG8_BAR;
    } else {
        PG8_STAGE(PG8_SB(0, 0), cB, voffB); PG8_STAGE(PG8_SA(0, 0), cA, voffA); PG8_STAGE(PG8_SB(0, 1), cB + hsB, voffB); PG8_STAGE(PG8_SA(0, 1), cA + hsA, voffA);
        if (wr == 1) PG8_BAR;
        PG8_WAIT_V(4); PG8_BAR;
        PG8_STAGE(PG8_SB(1, 0), cB + kstep, voffB); PG8_STAGE(PG8_SA(1, 0), cA + kstep, voffA); PG8_STAGE(PG8_SB(1, 1), cB + hsB + kstep, voffB);
        PG8_WAIT_V(6); PG8_BAR;
    }
    for (;;) {
        const bool has_next = S.next(ui + 1, nxt);
        const char* nA = has_next ? (const char*)g.A + (size_t)nxt.pm * tsA + (size_t)((nxt.pn >> g.ks_sh) & g.ks_msk) * 256 : cA; const char* nB = has_next ? (const char*)g.Bt + (size_t)nxt.pn * tsB : cB;
        for (int t = 0; t < nt; t += 2) {
            const bool last = (t == nt - 2);
            const char* a1 = cA + (size_t)(t + 1) * kstep;
            const char* a2 = last ? nA : cA + (size_t)(t + 2) * kstep; const char* b2 = last ? nB : cB + (size_t)(t + 2) * kstep;
            const char* a3 = a2 + kstep; const char* b3 = b2 + kstep;
            if (last && has_next) S.a_ready(nxt);
            if constexpr (SP2) {
            PG8_LDB(B0, 0, 0); PG8_LDB(B1, 0, 1); PG8_SCHED; PG8_LDA(At, 0, 0); PG8_STAGE(PG8_SA(1, 1), a1 + hsA, voffA);
            PG8_WAIT_V(8); PG8_WAIT_L(0); PG8_BAR; PG8_MMA(0, 0, At, B0); PG8_MMA(0, 1, At, B1); PG8_BAR; PG8_SCHED;
            PG8_LDA(At, 0, 1); PG8_STAGE(PG8_SB(0, 0), b2, voffB); PG8_STAGE(PG8_SB(0, 1), b2 + hsB, voffB); PG8_STAGE(PG8_SA(0, 0), a2, voffA);
            PG8_WAIT_V(8); PG8_WAIT_L(0); PG8_BAR; PG8_MMA(1, 0, At, B0); PG8_MMA(1, 1, At, B1); PG8_BAR; PG8_SCHED;
            PG8_LDB(B0, 1, 0); PG8_LDB(B1, 1, 1); PG8_SCHED; PG8_LDA(At, 1, 0); PG8_STAGE(PG8_SA(0, 1), a2 + hsA, voffA);
            PG8_WAIT_V(8); PG8_WAIT_L(0); PG8_BAR; PG8_MMA(0, 0, At, B0); PG8_MMA(0, 1, At, B1); PG8_BAR; PG8_SCHED;
            PG8_LDA(At, 1, 1); PG8_STAGE(PG8_SB(1, 0), b3, voffB); PG8_STAGE(PG8_SB(1, 1), b3 + hsB, voffB); PG8_STAGE(PG8_SA(1, 0), a3, voffA);
            PG8_WAIT_V(8); PG8_WAIT_L(0); PG8_BAR; PG8_MMA(1, 0, At, B0); PG8_MMA(1, 1, At, B1); PG8_BAR; PG8_SCHED;
            } else {
            PG8_LDB(B0, 0, 0); PG8_SCHED; PG8_LDA(At, 0, 0); PG8_STAGE(PG8_SA(1, 1), a1 + hsA, voffA);
            PG8_WAIT_L(8); PG8_BAR; PG8_WAIT_L(0); PG8_MMA(0, 0, At, B0); PG8_BAR; PG8_SCHED;
            PG8_LDB(B1, 0, 1); PG8_STAGE(PG8_SB(0, 0), b2, voffB);
            PG8_BAR; PG8_WAIT_L(0); PG8_MMA(0, 1, At, B1); PG8_BAR;
            PG8_LDA(At, 0, 1); PG8_STAGE(PG8_SA(0, 0), a2, voffA);
            PG8_BAR; PG8_WAIT_L(0); PG8_MMA(1, 0, At, B0); PG8_BAR; PG8_SCHED;
            PG8_STAGE(PG8_SB(0, 1), b2 + hsB, voffB);
            PG8_WAIT_V(6); PG8_BAR; PG8_MMA(1, 1, At, B1); PG8_BAR;
            PG8_LDB(B0, 1, 0); PG8_SCHED; PG8_LDA(At, 1, 0); PG8_STAGE(PG8_SA(0, 1), a2 + hsA, voffA);
            PG8_WAIT_L(8); PG8_BAR; PG8_WAIT_L(0); PG8_MMA(0, 0, At, B0); PG8_BAR; PG8_SCHED;
            PG8_LDB(B1, 1, 1); PG8_STAGE(PG8_SB(1, 0), b3, voffB);
            PG8_BAR; PG8_WAIT_L(0); PG8_MMA(0, 1, At, B1); PG8_BAR;
            PG8_LDA(At, 1, 1); PG8_STAGE(PG8_SA(1, 0), a3, voffA);
            PG8_BAR; PG8_WAIT_L(0); PG8_MMA(1, 0, At, B0); PG8_BAR; PG8_SCHED;
            PG8_STAGE(PG8_SB(1, 1), b3 + hsB, voffB);
            PG8_WAIT_V(6); PG8_BAR; PG8_MMA(1, 1, At, B1); PG8_BAR;
            }
        }
        if constexpr (ALIGN_EPI) { if (wr == 0) PG8_BAR; }
        if constexpr (!Epi::AFTER_DRAIN) { E(acc, cur, wr, wc, fr, fq, lds); S.done(cur); }
        if (!has_next) break;
#pragma unroll
        for (int a = 0; a < 2; ++a)
#pragma unroll
            for (int b = 0; b < 2; ++b)
#pragma unroll
                for (int m = 0; m < 4; ++m)
#pragma unroll
                    for (int n = 0; n < 2; ++n) acc[a][b][m][n] = (f32x4){0.f, 0.f, 0.f, 0.f};
        cur = nxt; cA = nA; cB = nB; ++ui;
        if constexpr (ALIGN_EPI) { if (wr == 1) PG8_BAR; }
    }
    PG8_WAIT_V(0);
    if constexpr (!ALIGN_EPI) { if (wr == 0) PG8_BAR; }
    PG8_BAR;
    if constexpr (Epi::AFTER_DRAIN) { E.fused(acc, cur, wr, wc, fr, fq, lds, wid, lane); S.done(cur); }
#undef PG8_SA
#undef PG8_SB
#undef PG8_STAGE
#undef PG8_LDA
#undef PG8_LDB
#undef PG8_MMA
#undef PG8_WAIT_V
#undef PG8_WAIT_L
#undef PG8_BAR
#undef PG8_SCHED
}
}

using pg8::PP;
constexpr int NWAVES = 8, NTHR = 512;
constexpr int D = 1024, MTOK = 16384, MCTX = 8192, NB_CTX = 32, T_CTX = 256, NB_LAT = 4, T_LAT = 2048, NSLOT = 5;
constexpr int DFF = 2816, NPROJ = 3840, NLORA = 2560, KLORA = 128, NGATE = 1024, KGATE = 128, NGU = 5632;
constexpr int C_R = 0, C_K = 512, C_V = 1024, C_LORA = 1536, C_XB = 1920, C_GB = 2176, C_Q = 2432, C_FF = 2688, C_IV = 3200, C_OG = 3456;
constexpr size_t OUT_Y = 0, OUT_RWKV = (size_t)MTOK * D, OUT_LRU = OUT_RWKV + (size_t)32 * 2 * 2 * 8 * 4096, OUT_HGRN = OUT_LRU + (size_t)32 * 2 * 2 * 256, OUT_END = OUT_HGRN + (size_t)32 * 2 * 2 * 4 * 4096;
constexpr size_t MiB = 1u << 20;
constexpr size_t WS_CTL = 0, CTL_ZERO_BYTES = 64 * 1024;
constexpr size_t WS_MODP = 1 * MiB;
constexpr size_t WS_MOD = 3 * MiB;
constexpr size_t WS_SP = WS_MOD + 256 * 1024;
constexpr size_t WS_W = 4 * MiB;
constexpr size_t W_IN = 0, W_OUT = W_IN + (size_t)NPROJ * D * 2, W_GU = W_OUT + (size_t)D * D * 2, W_DOWN = W_GU + (size_t)NGU * D * 2,
                 W_LORA = W_DOWN + (size_t)D * DFF * 2, W_GATE = W_LORA + (size_t)NLORA * KLORA * 2, W_END = W_GATE + (size_t)NGATE * KGATE * 2;
static_assert(WS_W + W_END <= 34 * MiB, "weights");
constexpr size_t WS_R1 = 34 * MiB;
constexpr size_t WS_P = 66 * MiB;
constexpr size_t WS_L = 182 * MiB;
constexpr size_t WS_U = 262 * MiB;
constexpr size_t WS_G = 270 * MiB;
constexpr size_t WS_OR = 302 * MiB;
constexpr size_t WS_OH = 334 * MiB;
constexpr size_t WS_GU = 66 * MiB;
constexpr size_t WS_ACT = 242 * MiB;
constexpr size_t WS_END = 350 * MiB;
static_assert(WS_P + (size_t)MTOK * PP * 2 <= WS_L && WS_L + (size_t)MTOK * NLORA * 2 <= WS_U && WS_OH + (size_t)2 * MTOK * 256 * 2 <= WS_END && WS_GU + (size_t)MTOK * NGU * 2 <= WS_ACT && WS_ACT + (size_t)MTOK * DFF * 2 <= WS_END, "d_ws map");
constexpr int CW_BAR = 1024;
constexpr int CW_QUEUE = 8192;
static_assert((CW_QUEUE + 512) * 4 <= (int)CTL_ZERO_BYTES && CW_BAR + 3456 <= CW_QUEUE, "ctl");
constexpr int RING_OFF = 0, RING_BYTES = 131072;
constexpr int LDSCTL_OFF = RING_BYTES, MISC_OFF = LDSCTL_OFF + 320, PTBL_OFF = LDSCTL_OFF + 512, JDESC_OFF = LDSCTL_OFF + 1024;
constexpr int LDS_BYTES = 147456;

#define GAS __attribute__((address_space(1)))
#define LAS __attribute__((address_space(3)))
typedef unsigned short bf16;
typedef unsigned v4u __attribute__((ext_vector_type(4)));
typedef unsigned v2u __attribute__((ext_vector_type(2)));
typedef float f32x4 __attribute__((ext_vector_type(4)));
typedef float f32x2 __attribute__((ext_vector_type(2)));
typedef GAS unsigned gu32;
#define RLX_AGENT __ATOMIC_RELAXED, __HIP_MEMORY_SCOPE_AGENT
#define LDS_WAIT() asm volatile("s_waitcnt lgkmcnt(0)" ::: "memory")
#define VM_WAIT() asm volatile("s_waitcnt vmcnt(0)" ::: "memory")
using pg8::cvt_pk_bf16; using pg8::fsigmoid; using pg8::ftanh; using pg8::bf_lo; using pg8::bf_hi;
__device__ __forceinline__ float bf2f(bf16 h) { return __uint_as_float((unsigned)h << 16); }
__device__ __forceinline__ bf16 f2bf(float f) { return (bf16)(cvt_pk_bf16(f, 0.f) & 0xffffu); }
template <int CTRL> __device__ __forceinline__ float dpp_mov(float v) { return __builtin_bit_cast(float, __builtin_amdgcn_update_dpp(0, __builtin_bit_cast(int, v), CTRL, 0xf, 0xf, true)); }
__device__ __forceinline__ float rowsum16(float v) { v += dpp_mov<0xB1>(v); v += dpp_mov<0x4E>(v); v += dpp_mov<0x141>(v); v += dpp_mov<0x140>(v); return v; }
__device__ __forceinline__ float wave_sum(float v) {
#pragma unroll
    for (int o = 1; o < 64; o <<= 1) v += __shfl_xor(v, o);
    return v;
}
#define XB_TMO      128
#define XB_XCNT(j)  (256  + 64 * (j))
#define XB_XSUB(j)  (1280 + 64 * (j))
#define XB_XGEN(j)  (2304 + 64 * (j))
#define XB_TOP      3328
#define XB_TOPGEN   3392
#define XCD_BAR_WORDS 3456
#define XB_SPIN_CAP (1u << 18)

__device__ __forceinline__ unsigned xb_ld(unsigned* p)              { return __hip_atomic_load(p, __ATOMIC_RELAXED, __HIP_MEMORY_SCOPE_AGENT); }
__device__ __forceinline__ unsigned xb_add(unsigned* p, unsigned v) { return __hip_atomic_fetch_add(p, v, __ATOMIC_RELAXED, __HIP_MEMORY_SCOPE_AGENT); }
__device__ __forceinline__ unsigned xb_xcc_id() { return (unsigned)__builtin_amdgcn_s_getreg((3 << 11) | 20) & 0xFu; }
#define XB_SPIN(cond, bar) do { unsigned _sp = 0; while (cond) { __builtin_amdgcn_s_sleep(1); \
    if ((++_sp & 255u) == 0u) { if (xb_ld(&(bar)[XB_TMO])) break; if (_sp > XB_SPIN_CAP) { atomicAdd(&(bar)[XB_TMO], 1u); break; } } } } while (0)

struct XcdBarrier {
    unsigned* bar; unsigned x;
    volatile LAS unsigned* st;
};

__device__ __forceinline__ XcdBarrier xcd_barrier_post(unsigned* bar, volatile LAS unsigned* st) {
    XcdBarrier b; b.bar = bar; b.x = xb_xcc_id(); b.st = st;
    if (threadIdx.x == 0) (void)xb_add(&bar[XB_XCNT(b.x)], 1u);
    return b;
}
__device__ __forceinline__ void xcd_barrier_complete(unsigned* bar, unsigned x, unsigned& nloc, unsigned& nx) {
    const unsigned G = gridDim.x * gridDim.y * gridDim.z;
    unsigned sum, cnt, mine, sp = 0u;
    for (;;) {
        sum = 0u; cnt = 0u; mine = 0u;
#pragma unroll
        for (unsigned j = 0; j < 16; ++j) { const unsigned c = xb_ld(&bar[XB_XCNT(j)]); sum += c; cnt += (c > 0u) ? 1u : 0u; mine = (j == x) ? c : mine; }
        if (sum == G) break;
        __builtin_amdgcn_s_sleep(1);
        if ((++sp & 255u) == 0u) { if (xb_ld(&bar[XB_TMO])) break; if (sp > XB_SPIN_CAP) { atomicAdd(&bar[XB_TMO], 1u); break; } }
    }
    nloc = mine > 0u ? mine : 1u; nx = cnt > 0u ? cnt : 1u;
}

__device__ __forceinline__ void xcd_barrier(const XcdBarrier& b) {
    asm volatile("s_waitcnt vmcnt(0)" ::: "memory");
    __syncthreads();
    if (threadIdx.x == 0) {
        unsigned* bar = b.bar;
        __builtin_amdgcn_s_waitcnt(0);
        unsigned nloc = b.st[0], nx = b.st[1];
        if (nloc == 0u) { xcd_barrier_complete(bar, b.x, nloc, nx); b.st[0] = nloc; b.st[1] = nx; }
        const unsigned old = xb_add(&bar[XB_XSUB(b.x)], 1u);
        const unsigned gen = old / nloc;
        if (old + 1u == (gen + 1u) * nloc) {
            __builtin_amdgcn_fence(__ATOMIC_RELEASE, "agent");
            asm volatile("s_waitcnt vmcnt(0)" ::: "memory");
            const unsigned og = xb_add(&bar[XB_TOP], 1u);
            const unsigned tg = og / nx;
            if (og + 1u == (tg + 1u) * nx) xb_add(&bar[XB_TOPGEN], 1u);
            else XB_SPIN(xb_ld(&bar[XB_TOPGEN]) == tg, bar);
            __builtin_amdgcn_fence(__ATOMIC_ACQUIRE, "agent");
            xb_add(&bar[XB_XGEN(b.x)], 1u);
            asm volatile("s_waitcnt vmcnt(0)" ::: "memory");
        } else {
            XB_SPIN(xb_ld(&bar[XB_XGEN(b.x)]) == gen, bar);
            __builtin_amdgcn_fence(__ATOMIC_ACQUIRE, "agent");
            asm volatile("s_waitcnt vmcnt(0)" ::: "memory");
        }
    }
    __syncthreads();
}


struct Args { const float* in[38]; float* out; unsigned char* ws; int ph_lo, ph_hi; };
enum InIdx { I_XP = 0, I_XS, I_SRWKV, I_SLRU, I_SHGRN, I_C, I_CCTX, I_ADAW, I_ADAB, I_NMIXG, I_NFFNG, I_WIN, I_WOUT, I_W0, I_WUP, I_A0, I_AUP, I_GUP, I_KK, I_KA, I_RK, I_LNW, I_LNB,
             I_LCW, I_LCB, I_LWA, I_LBA, I_LWX, I_LBX, I_LLAM, I_HLB, I_HNG, I_FWG, I_FWU, I_FCW, I_FCB, I_FWD, I_FING };

struct InTbl { const LAS unsigned long long* t;
    __device__ __forceinline__ const float* operator[](int i) const { const unsigned long long v = t[i];
        const unsigned lo = __builtin_amdgcn_readfirstlane((unsigned)v), hi = __builtin_amdgcn_readfirstlane((unsigned)(v >> 32)); return (const float*)(const __attribute__((address_space(1))) float*)(((unsigned long long)hi << 32) | lo); } };
struct Ctx { InTbl in; float* out; unsigned char* ws; };
__device__ __forceinline__ int slot_of_row(int r) { return r < MCTX ? 0 : 1 + ((r - MCTX) >> 11); }

__device__ __forceinline__ void transpose_item(const float* W, int K, int N, bf16* WT, int item, int drow_mode, LAS float* scr, int lane) {
    const int nblk = N / 32, kb = item / nblk, nb = item % nblk, k0 = 64 * kb, n0 = 32 * nb;
    int drow0 = n0;
    if (drow_mode == 1) drow0 = (n0 >> 7) * 256 + (n0 & 127);
    if (drow_mode == 2) drow0 = (n0 >> 7) * 256 + 128 + (n0 & 127);
#pragma unroll 8
    for (int i = 0; i < 32; ++i) { const int kk = 2 * i + (lane >> 5); scr[kk * 33 + (lane & 31)] = W[(size_t)(k0 + kk) * N + n0 + (lane & 31)]; }
    LDS_WAIT();
    const int c = lane & 7;
#pragma unroll
    for (int j = 0; j < 4; ++j) { const int n = (lane >> 3) + 8 * j; const LAS float* s = scr + (8 * c) * 33 + n;
        v4u o; o.x = cvt_pk_bf16(s[0 * 33], s[1 * 33]); o.y = cvt_pk_bf16(s[2 * 33], s[3 * 33]); o.z = cvt_pk_bf16(s[4 * 33], s[5 * 33]); o.w = cvt_pk_bf16(s[6 * 33], s[7 * 33]);
        *(v4u*)(WT + (size_t)(drow0 + n) * K + k0 + 8 * c) = o; }
    LDS_WAIT();
}
__device__ __forceinline__ void convert_weights(const Ctx& a, int l, LAS unsigned char* lds, int gw, int NGW, int wave, int lane, int gtid, int NGT) {
    LAS float* scr = (LAS float*)(lds + wave * 8704);
    unsigned char* wb = a.ws + WS_W;
    constexpr int I_IN = (D / 64) * (PP / 32), I_OUT = (D / 64) * (D / 32), I_G = (D / 64) * (DFF / 32), I_DN = (DFF / 64) * (D / 32);
    constexpr int NITEMS = I_IN + I_OUT + 2 * I_G + I_DN;
    const float* p_win = a.in[I_WIN]; const float* p_wout = a.in[I_WOUT]; const float* p_fwg = a.in[I_FWG]; const float* p_fwu = a.in[I_FWU]; const float* p_fwd = a.in[I_FWD];
    for (int it = gw; it < NITEMS; it += NGW) {
        int r = it;
        if (r < I_IN) { transpose_item(p_win + (size_t)l * D * PP, D, PP, (bf16*)(wb + W_IN), r, 0, scr, lane); continue; } r -= I_IN;
        if (r < I_OUT) { transpose_item(p_wout + (size_t)l * D * D, D, D, (bf16*)(wb + W_OUT), r, 0, scr, lane); continue; } r -= I_OUT;
        if (r < I_G) { transpose_item(p_fwg + (size_t)l * D * DFF, D, DFF, (bf16*)(wb + W_GU), r, 1, scr, lane); continue; } r -= I_G;
        if (r < I_G) { transpose_item(p_fwu + (size_t)l * D * DFF, D, DFF, (bf16*)(wb + W_GU), r, 2, scr, lane); continue; } r -= I_G;
        transpose_item(p_fwd + (size_t)l * DFF * D, DFF, D, (bf16*)(wb + W_DOWN), r, 0, scr, lane);
    }
    constexpr int CH_Z = (NPROJ - PP) * D / 8, CH_L = NLORA * KLORA / 8, CH_G = NGATE * KGATE / 8;
    const float* wup = a.in[I_WUP] + (size_t)l * 2 * 64 * 512; const float* aup = a.in[I_AUP] + (size_t)l * 2 * 64 * 512; const float* gup = a.in[I_GUP] + (size_t)l * 128 * 512;
    const float* lwa = a.in[I_LWA] + (size_t)l * 2 * 4 * 64 * 64; const float* lwx = a.in[I_LWX] + (size_t)l * 2 * 4 * 64 * 64;
    for (int c = gtid; c < CH_Z + CH_L + CH_G; c += NGT) {
        float v[8];
#pragma unroll
        for (int j = 0; j < 8; ++j) v[j] = 0.f;
        bf16* dst;
        if (c < CH_Z) { dst = (bf16*)(wb + W_IN) + (size_t)PP * D + (size_t)c * 8; }
        else if (c < CH_Z + CH_L) {
            const int e = (c - CH_Z) * 8, n = e / KLORA, k0 = e % KLORA; dst = (bf16*)(wb + W_LORA) + e;
            const int grp = n >> 9, cc = n & 511;
            if (grp < 4) { if ((k0 >> 6) == (grp & 1)) { const float* src = (grp < 2 ? wup : aup) + (size_t)((grp & 1) * 64 + (k0 & 63)) * 512 + cc;
#pragma unroll
                    for (int j = 0; j < 8; ++j) v[j] = src[(size_t)j * 512]; } }
            else { const float* src = gup + (size_t)k0 * 512 + cc;
#pragma unroll
                    for (int j = 0; j < 8; ++j) v[j] = src[(size_t)j * 512]; }
        } else {
            const int e = (c - CH_Z - CH_L) * 8, n = e / KGATE, k0 = e % KGATE; dst = (bf16*)(wb + W_GATE) + e;
            const int pn = n >> 8, d = pn >> 1, ch = (pn & 1) * 128 + (n & 127), blk = ch >> 6, jj = ch & 63;
            if ((k0 >> 6) == (blk & 1)) { const float* src = (((n >> 7) & 1) ? lwx : lwa) + (size_t)(((d * 4 + blk) * 64 + (k0 & 63)) * 64) + jj;
#pragma unroll
                for (int j = 0; j < 8; ++j) v[j] = src[(size_t)j * 64]; }
        }
        v4u o; o.x = cvt_pk_bf16(v[0], v[1]); o.y = cvt_pk_bf16(v[2], v[3]); o.z = cvt_pk_bf16(v[4], v[5]); o.w = cvt_pk_bf16(v[6], v[7]);
        *(v4u*)dst = o;
    }
    if (gtid < 512) { const float lam = a.in[I_LLAM][l * 512 + gtid]; ((float*)(a.ws + WS_SP))[l * 512 + gtid] = log1pf(__expf(-lam)); }
}
__device__ __forceinline__ void mod_partials(const Ctx& a, LAS unsigned char* lds, int bid, int G, int tid) {
    LAS float* sc = (LAS float*)lds;
    const float* cctx = a.in[I_CCTX]; const float* cc = a.in[I_C]; const float* adaw = a.in[I_ADAW];
    for (int it = bid; it < 2 * 12 * 8; it += G) {
        const int l = it / 96, nb = (it % 96) / 8, ks = it % 8;
        __syncthreads();
        for (int e = tid; e < NSLOT * 128; e += NTHR) { const int s = e >> 7, k = ks * 128 + (e & 127);
            const float c = s == 0 ? cctx[k] : cc[(s - 1) * D + k]; sc[e] = c * fsigmoid(c); }
        __syncthreads();
        const int n = nb * 512 + tid; const float* wp = adaw + ((size_t)l * D + ks * 128) * 6144 + n;
        float acc[NSLOT];
#pragma unroll
        for (int s = 0; s < NSLOT; ++s) acc[s] = 0.f;
#pragma unroll 8
        for (int k = 0; k < 128; ++k) { const float w = wp[(size_t)k * 6144];
#pragma unroll
            for (int s = 0; s < NSLOT; ++s) acc[s] += sc[s * 128 + k] * w; }
        float* pp = (float*)(a.ws + WS_MODP) + ((size_t)(l * 8 + ks) * NSLOT) * 6144 + n;
#pragma unroll
        for (int s = 0; s < NSLOT; ++s) pp[(size_t)s * 6144] = acc[s];
    }
    __syncthreads();
}
__device__ __forceinline__ void mod_finalize(const Ctx& a, int gtid, int NGT) {
    const float* adab = a.in[I_ADAB];
    for (int e = gtid; e < 2 * NSLOT * 6144; e += NGT) { const int l = e / (NSLOT * 6144), r = e % (NSLOT * 6144), n = r % 6144;
        float s = adab[l * 6144 + n]; const float* pp = (const float*)(a.ws + WS_MODP) + (size_t)l * 8 * NSLOT * 6144 + r;
#pragma unroll
        for (int ks = 0; ks < 8; ++ks) s += pp[(size_t)ks * NSLOT * 6144];
        ((float*)(a.ws + WS_MOD))[e] = s; }
}

__device__ __forceinline__ void phase_norm(const Ctx& a, LAS unsigned char* lds, int l, int which, bool from_partials, bool x_from_inputs, int bid, int G, int tid, int wave, int lane) {
    LAS float* gs = (LAS float*)lds; LAS float* sh = gs + D;
    const float* gw = a.in[which ? I_NFFNG : I_NMIXG] + l * D; const float* adab = a.in[I_ADAB]; const float* xp = a.in[I_XP]; const float* xs = a.in[I_XS];
    bf16* H = (bf16*)(a.ws + WS_R1);
    for (int rb = bid; rb < MTOK / 64; rb += G) {
        const int r0 = rb * 64, slot = slot_of_row(r0);
        __syncthreads();
        for (int c = tid; c < D; c += NTHR) {
            float shv, scv;
            if (from_partials) {
                shv = adab[l * 6144 + (which * 3 + 0) * D + c]; scv = adab[l * 6144 + (which * 3 + 1) * D + c];
                const float* pp = (const float*)(a.ws + WS_MODP) + ((size_t)(l * 8) * NSLOT + slot) * 6144;
#pragma unroll
                for (int ks = 0; ks < 8; ++ks) { shv += pp[(size_t)ks * NSLOT * 6144 + (which * 3 + 0) * D + c]; scv += pp[(size_t)ks * NSLOT * 6144 + (which * 3 + 1) * D + c]; }
            } else {
                const float* mp = (const float*)(a.ws + WS_MOD) + ((size_t)l * NSLOT + slot) * 6144;
                shv = mp[(which * 3 + 0) * D + c]; scv = mp[(which * 3 + 1) * D + c];
            }
            gs[c] = gw[c] * (1.0f + scv); sh[c] = shv;
        }
        __syncthreads();
        for (int i = 0; i < 8; ++i) {
            const int r = r0 + wave * 8 + i;
            const float* xr = x_from_inputs ? (r < MCTX ? xp + (size_t)r * D : xs + (size_t)(r - MCTX) * D) : a.out + (size_t)r * D;
            f32x4 v[4]; float ss = 0.f;
#pragma unroll
            for (int q = 0; q < 4; ++q) { v[q] = *(const f32x4*)(xr + 4 * lane + 256 * q); ss += (v[q].x * v[q].x + v[q].y * v[q].y) + (v[q].z * v[q].z + v[q].w * v[q].w); }
            const float rinv = rsqrtf(wave_sum(ss) * (1.0f / D) + 1e-6f);
#pragma unroll
            for (int q = 0; q < 4; ++q) { const int c = 4 * lane + 256 * q; const f32x4 g4 = *(const LAS f32x4*)(gs + c), s4 = *(const LAS f32x4*)(sh + c);
                const f32x4 o = v[q] * rinv * g4 + s4; v2u w; w.x = cvt_pk_bf16(o.x, o.y); w.y = cvt_pk_bf16(o.z, o.w);
                *(v2u*)(H + (size_t)r * D + c) = w; }
        }
    }
    __syncthreads();
}
__device__ __forceinline__ void phase_final_norm(const Ctx& a, int gw, int NGW, int lane) {
    const float* g = a.in[I_FING];
    f32x4 g4[4];
#pragma unroll
    for (int q = 0; q < 4; ++q) g4[q] = *(const f32x4*)(g + 4 * lane + 256 * q);
    for (int r = gw; r < MTOK; r += NGW) {
        float* xr = a.out + (size_t)r * D; f32x4 v[4]; float ss = 0.f;
#pragma unroll
        for (int q = 0; q < 4; ++q) { v[q] = *(const f32x4*)(xr + 4 * lane + 256 * q); ss += (v[q].x * v[q].x + v[q].y * v[q].y) + (v[q].z * v[q].z + v[q].w * v[q].w); }
        const float rinv = rsqrtf(wave_sum(ss) * (1.0f / D) + 1e-6f);
#pragma unroll
        for (int q = 0; q < 4; ++q) *(f32x4*)(xr + 4 * lane + 256 * q) = v[q] * rinv * g4[q];
    }
}
__device__ __forceinline__ void phase_lru_conv(const Ctx& a, int l, int gtid, int NGT) {
    const bf16* P = (const bf16*)(a.ws + WS_P); bf16* U = (bf16*)(a.ws + WS_U);
    const float* cw = a.in[I_LCW] + l * 4 * 256; const float* cb = a.in[I_LCB] + l * 256;
    for (int it = gtid; it < MTOK * 32; it += NGT) {
        const int r = it >> 5, c0 = (it & 31) * 8;
        const int tt = r < MCTX ? (r & (T_CTX - 1)) : ((r - MCTX) & (T_LAT - 1)), Ts = r < MCTX ? T_CTX : T_LAT;
        float acc[8];
#pragma unroll
        for (int j = 0; j < 8; ++j) acc[j] = cb[c0 + j];
#pragma unroll
        for (int k = 0; k < 4; ++k) { const int t2 = tt + k - 2; if (t2 < 0 || t2 >= Ts) continue;
            const v4u x = *(const v4u*)(P + (size_t)(r + k - 2) * PP + C_XB + c0);
            const float xv[8] = {bf_lo(x.x), bf_hi(x.x), bf_lo(x.y), bf_hi(x.y), bf_lo(x.z), bf_hi(x.z), bf_lo(x.w), bf_hi(x.w)};
#pragma unroll
            for (int j = 0; j < 8; ++j) acc[j] += cw[k * 256 + c0 + j] * xv[j]; }
        v4u o; o.x = cvt_pk_bf16(acc[0], acc[1]); o.y = cvt_pk_bf16(acc[2], acc[3]); o.z = cvt_pk_bf16(acc[4], acc[5]); o.w = cvt_pk_bf16(acc[6], acc[7]);
        *(v4u*)(U + (size_t)r * 256 + c0) = o;
    }
}

constexpr int SCAN_BUF_BYTES = 49152;
constexpr int SCAN_OST_OFF = 2 * SCAN_BUF_BYTES, SCAN_OST_BYTES = 8192;
static_assert(SCAN_OST_OFF + 2 * SCAN_OST_BYTES <= RING_BYTES, "scan LDS");
template <int CTRL> __device__ __forceinline__ float dpp_add(float v) { return v + dpp_mov<CTRL>(v); }
__device__ __forceinline__ float fma_s(float a, float b, float c) { float d; asm("v_fma_f32 %0, %1, %2, %3" : "=v"(d) : "v"(a), "v"(b), "v"(c)); return d; }
__device__ __forceinline__ float fnma_s(float a, float b, float c) { float d; asm("v_fma_f32 %0, -%1, %2, %3" : "=v"(d) : "v"(a), "v"(b), "v"(c)); return d; }
__device__ __forceinline__ float mul_s(float a, float b) { float d; asm("v_mul_f32 %0, %1, %2" : "=v"(d) : "v"(a), "v"(b)); return d; }
__device__ __forceinline__ float add_s(float a, float b) { float d; asm("v_add_f32 %0, %1, %2" : "=v"(d) : "v"(a), "v"(b)); return d; }
__device__ __forceinline__ float rowsum8(float v) { v = dpp_add<0xB1>(v); v = dpp_add<0x4E>(v); v = dpp_add<0x141>(v); return v; }

struct SeqInfo { int row0, T, bl; bool latent; };
__device__ __forceinline__ SeqInfo seq_info(int b) { SeqInfo s; s.latent = b >= NB_CTX; s.bl = s.latent ? b - NB_CTX : b; s.row0 = s.latent ? MCTX + s.bl * T_LAT : b * T_CTX; s.T = s.latent ? T_LAT : T_CTX; return s; }
struct Combo { int b, h, d; };

template <int MIX  , int RV, int NW>
__device__ __forceinline__ void scan_unit(const Ctx& a, LAS unsigned char* lds, int l, Combo c0_, Combo c1_, int rh, int tid, int wave, int lane) {
    constexpr int NCOMBO = RV == 2 ? 2 : 1, TCX = 32 / NCOMBO, NARR = MIX == 0 ? 6 : 4, VA = NARR - 1;
    constexpr int ROWS_U = NW == 4 ? 32 : 64, VPT = ROWS_U / 16;
    constexpr int CFL = NARR * TCX * 64;
    static_assert(NCOMBO * CFL * 4 <= SCAN_BUF_BYTES && NCOMBO * TCX * 64 * 4 <= SCAN_OST_BYTES, "scan LDS carve");
    const bf16* P = (const bf16*)(a.ws + WS_P); const bf16* L = (const bf16*)(a.ws + WS_L);
    const int pslot = NCOMBO == 2 ? tid >> 8 : 0, tok = NCOMBO == 2 ? (tid >> 4) & 15 : tid >> 4, cq = tid & 15;
    const Combo pc = pslot ? c1_ : c0_;
    const SeqInfo psq = seq_info(pc.b);
    const int nch = psq.T / TCX, c0 = pc.h * 64 + 4 * cq;
    float pc0[4], pc1[4];
    { const float* t0 = MIX == 0 ? a.in[I_KK] : a.in[I_HLB]; const float* t1 = MIX == 0 ? a.in[I_KA] : t0;
#pragma unroll
    for (int j = 0; j < 4; ++j) {
        if (MIX == 0) { pc0[j] = t0[l * 512 + c0 + j]; pc1[j] = t1[l * 512 + c0 + j]; }
        else { float lb = 0.f; if (l == 1) lb = fsigmoid(t0[(pc.d * 2 + 1) * 256 + c0 + j] - t0[(pc.d * 2 + 0) * 256 + c0 + j]); pc0[j] = lb; pc1[j] = 1.0f - lb; }
    } }
    v2u raw[5];
    auto prep_load = [&](int c) {
        const int t0 = pc.d == 0 ? c * TCX : psq.T - (c + 1) * TCX; const size_t row = (size_t)(psq.row0 + t0 + tok);
        if (MIX == 0) {
            raw[0] = *(const v2u*)(P + row * PP + C_R + c0); raw[1] = *(const v2u*)(P + row * PP + C_K + c0); raw[2] = *(const v2u*)(P + row * PP + C_V + c0);
            raw[3] = *(const v2u*)(L + row * NLORA + pc.d * 512 + c0); raw[4] = *(const v2u*)(L + row * NLORA + 1024 + pc.d * 512 + c0);
        } else {
            raw[0] = *(const v2u*)(P + row * PP + C_Q + c0); raw[1] = *(const v2u*)(P + row * PP + C_FF + pc.d * 256 + c0); raw[2] = *(const v2u*)(P + row * PP + C_IV + c0);
        }
    };
    auto prep_store = [&](int bufi) {
        LAS float* buf = (LAS float*)(lds + bufi * SCAN_BUF_BYTES) + pslot * CFL + tok * 64 + 4 * cq;
        if (MIX == 0) {
            const f32x4 r4 = {bf_lo(raw[0].x), bf_hi(raw[0].x), bf_lo(raw[0].y), bf_hi(raw[0].y)};
            const f32x4 k4 = {bf_lo(raw[1].x), bf_hi(raw[1].x), bf_lo(raw[1].y), bf_hi(raw[1].y)};
            const f32x4 v4 = {bf_lo(raw[2].x), bf_hi(raw[2].x), bf_lo(raw[2].y), bf_hi(raw[2].y)};
            const f32x4 e4 = {bf_lo(raw[3].x), bf_hi(raw[3].x), bf_lo(raw[3].y), bf_hi(raw[3].y)};
            const f32x4 a4 = {bf_lo(raw[4].x), bf_hi(raw[4].x), bf_lo(raw[4].y), bf_hi(raw[4].y)};
            f32x4 kf, w4, b4, kd;
#pragma unroll
            for (int j = 0; j < 4; ++j) kf[j] = k4[j] * pc0[j];
            const float ss = rowsum16((kf[0] * kf[0] + kf[1] * kf[1]) + (kf[2] * kf[2] + kf[3] * kf[3]));
            const float rn = rsqrtf(ss + 1e-12f);
#pragma unroll
            for (int j = 0; j < 4; ++j) { kf[j] *= rn; w4[j] = __builtin_amdgcn_exp2f(-1.44269504089f * e4[j]); b4[j] = kf[j] * a4[j]; kd[j] = k4[j] * (1.0f + (a4[j] - 1.0f) * pc1[j]); }
            *(LAS f32x4*)(buf + 0 * TCX * 64) = kf; *(LAS f32x4*)(buf + 1 * TCX * 64) = w4; *(LAS f32x4*)(buf + 2 * TCX * 64) = b4;
            *(LAS f32x4*)(buf + 3 * TCX * 64) = kd; *(LAS f32x4*)(buf + 4 * TCX * 64) = r4; *(LAS f32x4*)(buf + 5 * TCX * 64) = v4;
        } else {
            const f32x4 q4 = {bf_lo(raw[0].x), bf_hi(raw[0].x), bf_lo(raw[0].y), bf_hi(raw[0].y)};
            const f32x4 g4 = {bf_lo(raw[1].x), bf_hi(raw[1].x), bf_lo(raw[1].y), bf_hi(raw[1].y)};
            const f32x4 v4 = {bf_lo(raw[2].x), bf_hi(raw[2].x), bf_lo(raw[2].y), bf_hi(raw[2].y)};
            f32x4 f4, kx, qs;
#pragma unroll
            for (int j = 0; j < 4; ++j) { f4[j] = pc0[j] + pc1[j] * fsigmoid(g4[j]); kx[j] = 1.0f - f4[j]; qs[j] = q4[j] * fsigmoid(q4[j]); }
            *(LAS f32x4*)(buf + 0 * TCX * 64) = f4; *(LAS f32x4*)(buf + 1 * TCX * 64) = kx; *(LAS f32x4*)(buf + 2 * TCX * 64) = qs; *(LAS f32x4*)(buf + 3 * TCX * 64) = v4;
        }
    };
    const bool scanner = wave < NW;
    const int sslot = NCOMBO == 2 ? wave >> 2 : 0, wcm = NCOMBO == 2 ? wave & 3 : wave;
    const Combo sc = sslot ? c1_ : c0_;
    const SeqInfo ssq = seq_info(sc.b);
    const int lv = lane >> 3, lk = lane & 7;
    const int grow = rh * 32 + wcm * 8 * RV + lv * RV;
    const int rloc = grow - rh * 32;
    f32x4 S[RV][2];
    if (scanner) {
        if (ssq.latent) {
            const float* stp = MIX == 0 ? a.in[I_SRWKV] : a.in[I_SHGRN];
#pragma unroll
            for (int j = 0; j < RV; ++j) {
                if (MIX == 0) { const float* st = stp + ((((size_t)ssq.bl * 2 + l) * 2 + sc.d) * 8 + sc.h) * 4096 + (size_t)(grow + j) * 64 + 8 * lk; S[j][0] = *(const f32x4*)st; S[j][1] = *(const f32x4*)(st + 4); }
                else { const float* st = stp + ((((size_t)ssq.bl * 2 + l) * 2 + sc.d) * 4 + sc.h) * 4096 + (grow + j);
                    S[j][0] = (f32x4){st[(8 * lk + 0) * 64], st[(8 * lk + 1) * 64], st[(8 * lk + 2) * 64], st[(8 * lk + 3) * 64]};
                    S[j][1] = (f32x4){st[(8 * lk + 4) * 64], st[(8 * lk + 5) * 64], st[(8 * lk + 6) * 64], st[(8 * lk + 7) * 64]}; }
            }
        } else {
#pragma unroll
            for (int j = 0; j < RV; ++j) { S[j][0] = (f32x4){0.f, 0.f, 0.f, 0.f}; S[j][1] = S[j][0]; }
        }
    }
    constexpr int OPITCH = MIX == 0 ? 512 : 256;
    auto write_out = [&](int c) {
        const int t0 = pc.d == 0 ? c * TCX : psq.T - (c + 1) * TCX;
        const LAS float* ost = (const LAS float*)(lds + SCAN_OST_OFF + (c & 1) * SCAN_OST_BYTES) + pslot * TCX * 64 + tok * 64 + cq * VPT;
        bf16* Od = (MIX == 0 ? (bf16*)(a.ws + WS_OR) : (bf16*)(a.ws + WS_OH)) + (size_t)pc.d * MTOK * OPITCH;
        bf16* op = Od + (size_t)(psq.row0 + t0 + tok) * OPITCH + pc.h * 64 + rh * 32 + cq * VPT;
        if (VPT == 2) { *(unsigned*)op = cvt_pk_bf16(ost[0], ost[1]); }
        else { v2u w; w.x = cvt_pk_bf16(ost[0], ost[1]); w.y = cvt_pk_bf16(ost[2], ost[3]); *(v2u*)op = w; }
    };
    struct Ops { f32x4 x[MIX == 0 ? 5 : 3][2]; float vv[RV]; };
    auto ld_ops = [&](Ops& o, const LAS float* buf, int i) {
        const LAS float* bp = buf + i * 64 + 8 * lk;
#pragma unroll
        for (int q = 0; q < (MIX == 0 ? 5 : 3); ++q) { o.x[q][0] = *(const LAS f32x4*)(bp + q * TCX * 64); o.x[q][1] = *(const LAS f32x4*)(bp + q * TCX * 64 + 4); }
#pragma unroll
        for (int j = 0; j < RV; ++j) o.vv[j] = buf[VA * TCX * 64 + i * 64 + grow + j];
    };
    float keep[RV];
    auto do_step = [&](const Ops& o, int s8) {
#pragma unroll
        for (int j = 0; j < RV; ++j) {
            f32x2 s[4] = {{S[j][0].x, S[j][0].y}, {S[j][0].z, S[j][0].w}, {S[j][1].x, S[j][1].y}, {S[j][1].z, S[j][1].w}};
#define OPK(q, p) ((f32x2){o.x[q][(p) >> 1][((p) & 1) * 2], o.x[q][(p) >> 1][((p) & 1) * 2 + 1]})
            float ov;
            if (MIX == 0) {
                f32x2 t = s[0] * OPK(0, 0); t = s[1] * OPK(0, 1) + t; t = s[2] * OPK(0, 2) + t; t = s[3] * OPK(0, 3) + t;
                f32x2 u[4];
#pragma unroll
                for (int p = 0; p < 4; ++p) u[p] = OPK(3, p) * o.vv[j];
                const float sa = rowsum8(t.x + t.y);
#pragma unroll
                for (int p = 0; p < 4; ++p) { s[p] = s[p] * OPK(1, p) + u[p]; s[p] = s[p] - OPK(2, p) * sa; }
                f32x2 q = s[0] * OPK(4, 0); q = s[1] * OPK(4, 1) + q; q = s[2] * OPK(4, 2) + q; q = s[3] * OPK(4, 3) + q;
                ov = rowsum8(q.x + q.y);
            } else {
#pragma unroll
                for (int p = 0; p < 4; ++p) s[p] = s[p] * OPK(0, p) + OPK(1, p) * o.vv[j];
                f32x2 q = s[0] * OPK(2, 0); q = s[1] * OPK(2, 1) + q; q = s[2] * OPK(2, 2) + q; q = s[3] * OPK(2, 3) + q;
                ov = rowsum8(q.x + q.y);
            }
#undef OPK
            S[j][0] = (f32x4){s[0].x, s[0].y, s[1].x, s[1].y}; S[j][1] = (f32x4){s[2].x, s[2].y, s[3].x, s[3].y};
            keep[j] = (lk == s8) ? ov : keep[j];
        }
    };
    __syncthreads();
    prep_load(0); prep_store(0);
    __syncthreads();
    for (int c = 0; c < nch; ++c) {
        if (c + 1 < nch) prep_load(c + 1);
        if (c > 0) write_out(c - 1);
        if (scanner) {
            const LAS float* buf = (const LAS float*)(lds + (c & 1) * SCAN_BUF_BYTES) + sslot * CFL;
            LAS float* ost = (LAS float*)(lds + SCAN_OST_OFF + (c & 1) * SCAN_OST_BYTES) + sslot * TCX * 64;
            const int i0 = sc.d == 0 ? 0 : TCX - 1, di = sc.d == 0 ? 1 : -1;
            Ops oa, ob;
            ld_ops(oa, buf, i0);
#pragma unroll 1
            for (int g = 0; g < TCX / 8; ++g) {
                const int ig = i0 + di * 8 * g;
#pragma unroll
                for (int j = 0; j < RV; ++j) keep[j] = 0.f;
#pragma unroll
                for (int s = 0; s < 8; s += 2) {
                    ld_ops(ob, buf, ig + di * (s + 1));
                    do_step(oa, s);
                    if (s + 2 < 8 || g + 1 < TCX / 8) ld_ops(oa, buf, ig + di * (s + 2));
                    do_step(ob, s + 1);
                }
#pragma unroll
                for (int j = 0; j < RV; ++j) ost[(ig + di * lk) * 64 + rloc + j] = keep[j];
            }
        }
        if (c + 1 < nch) prep_store((c + 1) & 1);
        __syncthreads();
    }
    write_out(nch - 1);
    if (scanner && !ssq.latent) {
#pragma unroll
        for (int j = 0; j < RV; ++j) {
            if (MIX == 0) { float* st = a.out + OUT_RWKV + ((((size_t)ssq.bl * 2 + l) * 2 + sc.d) * 8 + sc.h) * 4096 + (size_t)(grow + j) * 64 + 8 * lk; *(f32x4*)st = S[j][0]; *(f32x4*)(st + 4) = S[j][1]; }
            else { float* st = a.out + OUT_HGRN + ((((size_t)ssq.bl * 2 + l) * 2 + sc.d) * 4 + sc.h) * 4096 + (grow + j);
                st[(8 * lk + 0) * 64] = S[j][0].x; st[(8 * lk + 1) * 64] = S[j][0].y; st[(8 * lk + 2) * 64] = S[j][0].z; st[(8 * lk + 3) * 64] = S[j][0].w;
                st[(8 * lk + 4) * 64] = S[j][1].x; st[(8 * lk + 5) * 64] = S[j][1].y; st[(8 * lk + 6) * 64] = S[j][1].z; st[(8 * lk + 7) * 64] = S[j][1].w; }
        }
    }
}

__device__ __forceinline__ float gelu_tanh(float x) { return 0.5f * x * (1.0f + ftanh(0.7978845608f * (x + 0.044715f * x * x * x))); }
constexpr int LRU_SL = 64;
struct LruTask { int b, cg, s; };
__device__ __forceinline__ LruTask lru_task(int r) { LruTask t; if (r < 512) { t.b = r >> 4; t.cg = (r >> 2) & 3; t.s = r & 3; } else { const int q = r - 512; t.b = NB_CTX + (q >> 7); t.cg = (q >> 5) & 3; t.s = q & 31; } return t; }
__device__ __forceinline__ void lru_pass1(const Ctx& a, int tsk, int lane) {
    const int d = tsk & 1; const LruTask t = lru_task(tsk >> 1); const SeqInfo sq = seq_info(t.b);
    const bf16* G = (const bf16*)(a.ws + WS_G); f32x2* AB = (f32x2*)(a.ws + WS_U);
    const int ch = t.cg * 64 + lane;
    const bf16* gp = G + (size_t)(sq.row0 + t.s * LRU_SL) * 1024 + d * 512 + ch;
    float A = 1.f, B = 0.f;
#pragma unroll 1
    for (int g = 0; g < LRU_SL / 16; ++g) {
        bf16 la[16], bb[16];
#pragma unroll
        for (int i = 0; i < 16; ++i) { const int tt = d == 0 ? g * 16 + i : LRU_SL - 1 - (g * 16 + i); la[i] = gp[(size_t)tt * 1024]; bb[i] = gp[(size_t)tt * 1024 + 256]; }
#pragma unroll
        for (int i = 0; i < 16; ++i) { const float av = __builtin_amdgcn_exp2f(bf2f(la[i])); A *= av; B = av * B + bf2f(bb[i]); }
    }
    AB[((size_t)(t.b * 2 + d) * 32 + t.s) * 256 + ch] = (f32x2){A, B};
}
__device__ __forceinline__ void lru_pass2(const Ctx& a, int l, int r, int lane) {
    const LruTask t = lru_task(r); const SeqInfo sq = seq_info(t.b);
    const bf16* G = (const bf16*)(a.ws + WS_G); const bf16* P = (const bf16*)(a.ws + WS_P); const f32x2* AB = (const f32x2*)(a.ws + WS_U); bf16* MIX = (bf16*)(a.ws + WS_R1);
    const int ch = t.cg * 64 + lane, nsl = sq.T / LRU_SL;
    const float* st = a.in[I_SLRU];
    float h = sq.latent ? st[(((size_t)sq.bl * 2 + l) * 2 + 0) * 256 + ch] : 0.f;
    for (int s2 = 0; s2 < t.s; ++s2) { const f32x2 ab = AB[((size_t)(t.b * 2 + 0) * 32 + s2) * 256 + ch]; h = ab.x * h + ab.y; }
    float hf[LRU_SL];
    const bf16* gp = G + (size_t)(sq.row0 + t.s * LRU_SL) * 1024 + ch;
#pragma unroll
    for (int g = 0; g < LRU_SL / 16; ++g) {
        bf16 la[16], bb[16];
#pragma unroll
        for (int i = 0; i < 16; ++i) { la[i] = gp[(size_t)(g * 16 + i) * 1024]; bb[i] = gp[(size_t)(g * 16 + i) * 1024 + 256]; }
#pragma unroll
        for (int i = 0; i < 16; ++i) { h = __builtin_amdgcn_exp2f(bf2f(la[i])) * h + bf2f(bb[i]); hf[g * 16 + i] = h; }
    }
    if (!sq.latent && t.s == nsl - 1) a.out[OUT_LRU + (((size_t)sq.bl * 2 + l) * 2 + 0) * 256 + ch] = h;
    h = sq.latent ? st[(((size_t)sq.bl * 2 + l) * 2 + 1) * 256 + ch] : 0.f;
    for (int s2 = nsl - 1; s2 > t.s; --s2) { const f32x2 ab = AB[((size_t)(t.b * 2 + 1) * 32 + s2) * 256 + ch]; h = ab.x * h + ab.y; }
    const bf16* pp = P + (size_t)(sq.row0 + t.s * LRU_SL) * PP + C_GB + ch;
    bf16* mp = MIX + (size_t)(sq.row0 + t.s * LRU_SL) * D + 512 + ch;
#pragma unroll
    for (int g = LRU_SL / 16 - 1; g >= 0; --g) {
        bf16 la[16], bb[16], gb[16];
#pragma unroll
        for (int i = 0; i < 16; ++i) { const int tt = g * 16 + 15 - i; la[i] = gp[(size_t)tt * 1024 + 512]; bb[i] = gp[(size_t)tt * 1024 + 768]; gb[i] = pp[(size_t)tt * PP]; }
#pragma unroll
        for (int i = 0; i < 16; ++i) { const int tt = g * 16 + 15 - i; h = __builtin_amdgcn_exp2f(bf2f(la[i])) * h + bf2f(bb[i]);
            mp[(size_t)tt * D] = f2bf((hf[tt] + h) * gelu_tanh(bf2f(gb[i]))); }
    }
    if (!sq.latent && t.s == 0) a.out[OUT_LRU + (((size_t)sq.bl * 2 + l) * 2 + 1) * 256 + ch] = h;
}

constexpr int NU_RL = 64 * 2, NU_HL = 32 * 2, NU_RC = 256, NU_HC = 128, NU_L1 = 256, NU_ALL = NU_RL + NU_HL + NU_RC + NU_HC + NU_L1;
__device__ __forceinline__ Combo rwkv_combo(int i) { Combo c; c.d = i & 1; c.h = (i >> 1) & 7; c.b = i >> 4; return c; }
__device__ __forceinline__ Combo hgrn_combo(int i) { Combo c; c.d = i & 1; c.h = (i >> 1) & 3; c.b = i >> 3; return c; }
__device__ __forceinline__ void phase_scans(const Ctx& a, LAS unsigned char* lds, volatile LAS unsigned* MISC, int l, int rep, int tid, int wave, int lane) {
    unsigned* head = (unsigned*)(a.ws + WS_CTL) + CW_QUEUE + 64 * (l * 4 + rep);
    for (;;) {
        __syncthreads();
        if (tid == 0) MISC[0] = __hip_atomic_fetch_add(head, 1u, RLX_AGENT);
        __syncthreads();
        int u = (int)MISC[0];
        if (u >= NU_ALL) break;
        if (u < NU_RL) { const Combo c = rwkv_combo(512 + (u >> 1)); scan_unit<0, 1, 4>(a, lds, l, c, c, u & 1, tid, wave, lane); continue; } u -= NU_RL;
        if (u < NU_HL) { const Combo c = hgrn_combo(256 + (u >> 1)); scan_unit<1, 1, 4>(a, lds, l, c, c, u & 1, tid, wave, lane); continue; } u -= NU_HL;
        if (u < NU_RC) { scan_unit<0, 2, 8>(a, lds, l, rwkv_combo(2 * u), rwkv_combo(2 * u + 1), 0, tid, wave, lane); continue; } u -= NU_RC;
        if (u < NU_HC) { scan_unit<1, 2, 8>(a, lds, l, hgrn_combo(2 * u), hgrn_combo(2 * u + 1), 0, tid, wave, lane); continue; } u -= NU_HC;
        lru_pass1(a, u * 8 + wave, lane);
    }
}

__device__ __forceinline__ void phase_post(const Ctx& a, int l, int gw, int NGW, int lane) {
    const bf16* P = (const bf16*)(a.ws + WS_P); const bf16* L = (const bf16*)(a.ws + WS_L);
    const bf16* ORf = (const bf16*)(a.ws + WS_OR); const bf16* ORb = ORf + (size_t)MTOK * 512;
    const bf16* OHf = (const bf16*)(a.ws + WS_OH); const bf16* OHb = OHf + (size_t)MTOK * 256;
    bf16* MIX = (bf16*)(a.ws + WS_R1);
    if (gw < 1024) lru_pass2(a, l, gw, lane);
    const int sub = lane >> 4, li = lane & 15;
    const float* p_rk = a.in[I_RK] + l * 512; const float* p_lnw = a.in[I_LNW] + l * 512; const float* p_lnb = a.in[I_LNB] + l * 512; const float* p_hng = a.in[I_HNG] + l * 256;
    for (int r = gw; r < MTOK; r += NGW) {
        const size_t row = (size_t)r;
#pragma unroll
        for (int pass = 0; pass < 2; ++pass) {
            const int h = 4 * pass + sub, c0 = h * 64 + 4 * li;
            const v2u of = *(const v2u*)(ORf + row * 512 + c0), ob = *(const v2u*)(ORb + row * 512 + c0);
            const v2u rr = *(const v2u*)(P + row * PP + C_R + c0), kk = *(const v2u*)(P + row * PP + C_K + c0), vv = *(const v2u*)(P + row * PP + C_V + c0);
            const v2u gg = *(const v2u*)(L + row * NLORA + 2048 + c0);
            f32x4 o = {bf_lo(of.x) + bf_lo(ob.x), bf_hi(of.x) + bf_hi(ob.x), bf_lo(of.y) + bf_lo(ob.y), bf_hi(of.y) + bf_hi(ob.y)};
            const f32x4 r4 = {bf_lo(rr.x), bf_hi(rr.x), bf_lo(rr.y), bf_hi(rr.y)}, k4 = {bf_lo(kk.x), bf_hi(kk.x), bf_lo(kk.y), bf_hi(kk.y)};
            const f32x4 v4 = {bf_lo(vv.x), bf_hi(vv.x), bf_lo(vv.y), bf_hi(vv.y)}, g4 = {bf_lo(gg.x), bf_hi(gg.x), bf_lo(gg.y), bf_hi(gg.y)};
            const f32x4 rk = *(const f32x4*)(p_rk + c0), lw = *(const f32x4*)(p_lnw + c0), lb = *(const f32x4*)(p_lnb + c0);
            const float mu = rowsum16((o.x + o.y) + (o.z + o.w)) * (1.0f / 64.0f);
            o = o - mu;
            const float var = rowsum16((o.x * o.x + o.y * o.y) + (o.z * o.z + o.w * o.w)) * (1.0f / 64.0f);
            const float rs = rsqrtf(var + 64e-5f);
            const float bon = rowsum16((r4.x * k4.x * rk.x + r4.y * k4.y * rk.y) + (r4.z * k4.z * rk.z + r4.w * k4.w * rk.w));
            const f32x4 y = (o * rs * lw + lb + v4 * bon) * g4;
            v2u w; w.x = cvt_pk_bf16(y.x, y.y); w.y = cvt_pk_bf16(y.z, y.w);
            *(v2u*)(MIX + row * D + c0) = w;
        }
        {
            const int c0 = sub * 64 + 4 * li;
            const v2u of = *(const v2u*)(OHf + row * 256 + c0), ob = *(const v2u*)(OHb + row * 256 + c0);
            const v2u gg = *(const v2u*)(P + row * PP + C_OG + c0);
            const f32x4 o = {bf_lo(of.x) + bf_lo(ob.x), bf_hi(of.x) + bf_hi(ob.x), bf_lo(of.y) + bf_lo(ob.y), bf_hi(of.y) + bf_hi(ob.y)};
            const f32x4 g4 = {bf_lo(gg.x), bf_hi(gg.x), bf_lo(gg.y), bf_hi(gg.y)};
            const f32x4 ng = *(const f32x4*)(p_hng + c0);
            const float ms = rowsum16((o.x * o.x + o.y * o.y) + (o.z * o.z + o.w * o.w)) * (1.0f / 64.0f);
            const float rs = rsqrtf(ms + 1e-6f);
            f32x4 y;
#pragma unroll
            for (int j = 0; j < 4; ++j) y[j] = o[j] * rs * ng[j] * (g4[j] * fsigmoid(g4[j]));
            v2u w; w.x = cvt_pk_bf16(y.x, y.y); w.y = cvt_pk_bf16(y.z, y.w);
            *(v2u*)(MIX + row * D + 768 + c0) = w;
        }
    }
}
__device__ __forceinline__ void phase_ffn_act(const Ctx& a, int l, int gtid, int NGT) {
    const bf16* GU = (const bf16*)(a.ws + WS_GU); bf16* ACT = (bf16*)(a.ws + WS_ACT);
    const float* cw = a.in[I_FCW] + l * 3 * DFF; const float* cb = a.in[I_FCB] + l * DFF;
    for (int it = gtid; it < (MTOK / 4) * (DFF / 8); it += NGT) {
        const int r0 = (it / (DFF / 8)) * 4, c0 = (it % (DFF / 8)) * 8;
        const int tt = r0 < MCTX ? (r0 & 255) : (r0 & 63), Ts = r0 < MCTX ? 256 : 64;
        const int gc = (c0 >> 7) * 256 + (c0 & 127);
        v4u gx[6], ux[4];
#pragma unroll
        for (int k = 0; k < 6; ++k) { const int t2 = tt + k - 1; gx[k] = (v4u){0u, 0u, 0u, 0u}; if (t2 >= 0 && t2 < Ts) gx[k] = *(const v4u*)(GU + (size_t)(r0 + k - 1) * NGU + gc); }
#pragma unroll
        for (int k = 0; k < 4; ++k) ux[k] = *(const v4u*)(GU + (size_t)(r0 + k) * NGU + gc + 128);
        float w0[8], w1[8], w2[8], bs[8];
#pragma unroll
        for (int j = 0; j < 8; ++j) { w0[j] = cw[c0 + j]; w1[j] = cw[DFF + c0 + j]; w2[j] = cw[2 * DFF + c0 + j]; bs[j] = cb[c0 + j]; }
#pragma unroll
        for (int k = 0; k < 4; ++k) {
            const v4u xa = gx[k], xb = gx[k + 1], xc = gx[k + 2], up = ux[k];
            const float va[8] = {bf_lo(xa.x), bf_hi(xa.x), bf_lo(xa.y), bf_hi(xa.y), bf_lo(xa.z), bf_hi(xa.z), bf_lo(xa.w), bf_hi(xa.w)};
            const float vb[8] = {bf_lo(xb.x), bf_hi(xb.x), bf_lo(xb.y), bf_hi(xb.y), bf_lo(xb.z), bf_hi(xb.z), bf_lo(xb.w), bf_hi(xb.w)};
            const float vc[8] = {bf_lo(xc.x), bf_hi(xc.x), bf_lo(xc.y), bf_hi(xc.y), bf_lo(xc.z), bf_hi(xc.z), bf_lo(xc.w), bf_hi(xc.w)};
            const float uv[8] = {bf_lo(up.x), bf_hi(up.x), bf_lo(up.y), bf_hi(up.y), bf_lo(up.z), bf_hi(up.z), bf_lo(up.w), bf_hi(up.w)};
            float acc[8];
#pragma unroll
            for (int j = 0; j < 8; ++j) { const float g = bs[j] + w0[j] * va[j] + w1[j] * vb[j] + w2[j] * vc[j]; acc[j] = g * fsigmoid(g) * uv[j]; }
            v4u o; o.x = cvt_pk_bf16(acc[0], acc[1]); o.y = cvt_pk_bf16(acc[2], acc[3]); o.z = cvt_pk_bf16(acc[4], acc[5]); o.w = cvt_pk_bf16(acc[6], acc[7]);
            *(v4u*)(ACT + (size_t)(r0 + k) * DFF + c0) = o;
        }
    }
}

#ifndef REP_K
#define REP_K -2
#define REP_N 0
#endif
constexpr int PHL = 10, PHLX = PHL + REP_N, N_PHASES = 1 + 2 * PHLX + 1;
__global__ void __launch_bounds__(NTHR, 2) trunk_fwd(Args args) {
    extern __shared__ __attribute__((aligned(16))) unsigned char lds_raw[];
    LAS unsigned char* lds = (LAS unsigned char*)lds_raw;
    volatile LAS unsigned* MISC = (volatile LAS unsigned*)(lds + MISC_OFF);
    const int G = gridDim.x, bid = blockIdx.x, NGW = G * NWAVES, NGT = G * NTHR;
    { const int tid = threadIdx.x;
    for (int u = tid; u < (LDS_BYTES - LDSCTL_OFF) / 4; u += NTHR) ((LAS unsigned*)(lds + LDSCTL_OFF))[u] = 0u;
    __syncthreads();
    if (tid == 0) {
#pragma unroll
        for (int i = 0; i < 38; ++i) ((LAS unsigned long long*)(lds + PTBL_OFF))[i] = (unsigned long long)args.in[i];
        LAS unsigned long long* jd = (LAS unsigned long long*)(lds + JDESC_OFF);
        unsigned char* w = args.ws; float* o = args.out;
#pragma unroll
        for (int l = 0; l < 2; ++l) {
            const unsigned long long modl = (unsigned long long)(w + WS_MOD) + (unsigned long long)l * NSLOT * 6144 * 4;
#pragma unroll
            for (int k = 0; k < PHL; ++k) {
                LAS unsigned long long* d = jd + (1 + PHL * l + k) * 12;
                unsigned long long A = 0, Bt = 0, O = 0, f0 = 0, f1 = 0, f2 = 0, U = 0, xo = 0; unsigned N = 0, K = 0, lda = 0, kind = 0xffu, ldc = 0, rowperm = 0, kssh = 0, ksmsk = 0;
                if (k == 1) { A = (unsigned long long)(w + WS_R1); Bt = (unsigned long long)(w + WS_W + W_IN); N = NPROJ; K = D; lda = D; kind = pg8::K_PROJ; ldc = PP; O = (unsigned long long)(w + WS_P); }
                if (k == 2) { A = (unsigned long long)(w + WS_P) + C_LORA * 2; Bt = (unsigned long long)(w + WS_W + W_LORA); N = NLORA; K = KLORA; lda = PP; kssh = 2; ksmsk = 3; kind = pg8::K_LORA; ldc = NLORA; O = (unsigned long long)(w + WS_L);
                    f0 = (unsigned long long)(args.in[I_W0] + l * 1024); f1 = (unsigned long long)(args.in[I_A0] + l * 1024); }
                if (k == 3) { A = (unsigned long long)(w + WS_U); Bt = (unsigned long long)(w + WS_W + W_GATE); N = NGATE; K = KGATE; lda = 256; kssh = 0; ksmsk = 1; kind = pg8::K_GATES; ldc = 1024; O = (unsigned long long)(w + WS_G);
                    f0 = (unsigned long long)(args.in[I_LBA] + l * 512); f1 = (unsigned long long)(args.in[I_LBX] + l * 512); f2 = (unsigned long long)(w + WS_SP) + (unsigned long long)l * 512 * 4; U = (unsigned long long)(w + WS_U); }
                if (k == 6) { A = (unsigned long long)(w + WS_R1); Bt = (unsigned long long)(w + WS_W + W_OUT); N = D; K = D; lda = D; kind = pg8::K_RESID;
                    f0 = l == 0 ? (unsigned long long)args.in[I_XP] : (unsigned long long)o; f1 = l == 0 ? (unsigned long long)args.in[I_XS] : (unsigned long long)(o + (size_t)MCTX * D); f2 = modl + 2 * D * 4; xo = (unsigned long long)o; }
                if (k == 8) { A = (unsigned long long)(w + WS_R1); Bt = (unsigned long long)(w + WS_W + W_GU); N = NGU; K = D; lda = D; kind = pg8::K_GUACT; ldc = DFF; O = (unsigned long long)(w + WS_ACT); rowperm = 1;
                    f0 = (unsigned long long)(args.in[I_FCW] + l * 3 * DFF); f1 = (unsigned long long)(args.in[I_FCB] + l * DFF); }
                if (k == 9) { A = (unsigned long long)(w + WS_ACT); Bt = (unsigned long long)(w + WS_W + W_DOWN); N = D; K = DFF; lda = DFF; kind = pg8::K_RESID;
                    f0 = (unsigned long long)o; f1 = (unsigned long long)(o + (size_t)MCTX * D); f2 = modl + 5 * D * 4; xo = (unsigned long long)o; }
                d[0] = A; d[1] = Bt; d[2] = O; d[3] = f0; d[4] = f1; d[5] = f2; d[6] = U; d[7] = xo;
                d[8] = ((unsigned long long)K << 32) | N; d[9] = ((unsigned long long)kind << 32) | lda; d[10] = ((unsigned long long)rowperm << 32) | ldc; d[11] = ((unsigned long long)ksmsk << 32) | kssh;
            }
        }
        jd[9] = 0xffull << 32; jd[(1 + 2 * PHL) * 12 + 9] = 0xffull << 32;
    }
    __syncthreads(); }
    LAS unsigned long long* ptbl = (LAS unsigned long long*)(lds + PTBL_OFF);
    float* const out0 = args.out; unsigned char* const ws0 = args.ws;
    const int lo = args.ph_lo, hi = args.ph_hi;
    XcdBarrier bar; bar.bar = (unsigned*)(ws0 + WS_CTL) + CW_BAR; bar.x = 0; bar.st = nullptr;
    if (hi - lo > 1) bar = xcd_barrier_post((unsigned*)(ws0 + WS_CTL) + CW_BAR, MISC + 8);
#pragma unroll 1
    for (int ph = lo; ph < hi; ++ph) {
        int tid_ = threadIdx.x; asm volatile("" : "+v"(tid_));
        const int tid = tid_, lane = tid & 63, wave = __builtin_amdgcn_readfirstlane(tid >> 6), gw = bid * NWAVES + wave, gtid = bid * NTHR + tid;
        unsigned long long out_u = (unsigned long long)out0, ws_u = (unsigned long long)ws0; asm volatile("" : "+s"(out_u), "+s"(ws_u));
        float* out_ = (float*)(GAS float*)out_u; unsigned char* ws = (unsigned char*)(GAS unsigned char*)ws_u;
        const Ctx cx{{ptbl}, out_, ws};
        int l = 0, k = -1;
        int rep = 0;
        if (ph == N_PHASES - 1) k = 100; else if (ph > 0) { l = (ph - 1) / PHLX; k = (ph - 1) % PHLX;
            if (REP_N > 0 && k > REP_K) { if (k <= REP_K + REP_N) { rep = k - REP_K; k = REP_K; } else k -= REP_N; } }
        {
            const LAS unsigned long long* d = (const LAS unsigned long long*)(lds + JDESC_OFF) + (k == -1 ? 0 : (k == 100 ? 1 + 2 * PHL : 1 + PHL * l + k)) * 12;
            unsigned long long q[12];
#pragma unroll
            for (int i = 0; i < 12; ++i) { const unsigned long long v = d[i];
                q[i] = ((unsigned long long)__builtin_amdgcn_readfirstlane((unsigned)(v >> 32)) << 32) | (unsigned)__builtin_amdgcn_readfirstlane((unsigned)v); }
            const unsigned kind = (unsigned)(q[9] >> 32);
            if (kind != 0xffu) {
                pg8::Gemm g; pg8::EpiAny E;
                g.A = (const bf16*)(const GAS bf16*)q[0]; g.Bt = (const bf16*)(const GAS bf16*)q[1]; g.M = MTOK; g.N = (int)(unsigned)q[8]; g.K = (int)(q[8] >> 32); g.lda = (int)(unsigned)q[9]; g.rowperm = (int)(q[10] >> 32); g.ks_sh = (int)(unsigned)q[11]; g.ks_msk = (int)(q[11] >> 32);
                E.kind = (int)kind; E.ldc = (int)(unsigned)q[10]; E.O = (bf16*)(GAS bf16*)q[2]; E.f0 = (const float*)(const GAS float*)q[3]; E.f1 = (const float*)(const GAS float*)q[4];
                E.f2 = (const float*)(const GAS float*)q[5]; E.U = (const bf16*)(const GAS bf16*)q[6]; E.xout = (float*)(GAS float*)q[7];
                pg8::StaticOrder S; S.init(MTOK, g.N, G, bid);
                pg8::gemm_phase<pg8::EpiAny, pg8::StaticOrder, true, true>(lds + RING_OFF, g, S, E);
            }
        }
        if (k == -1) { mod_partials(cx, lds, bid, G, tid); convert_weights(cx, 0, lds, gw, NGW, wave, lane, gtid, NGT); }
        else if (k == 0) { if (l == 0) mod_finalize(cx, gtid, NGT); else convert_weights(cx, l, lds, gw, NGW, wave, lane, gtid, NGT);
            phase_norm(cx, lds, l, 0, l == 0, l == 0, bid, G, tid, wave, lane); }
        else if (k == 2) phase_lru_conv(cx, l, gtid, NGT);
        else if (k == 4) phase_scans(cx, lds, MISC, l, rep, tid, wave, lane);
        else if (k == 5) phase_post(cx, l, gw, NGW, lane);
        else if (k == 7) phase_norm(cx, lds, l, 1, false, false, bid, G, tid, wave, lane);
        else if (k == 100) phase_final_norm(cx, gw, NGW, lane);
        if (ph + 1 < hi) xcd_barrier(bar);
    }
}

#ifndef MK_PER_PHASE
#define MK_PER_PHASE 0
#endif
extern "C" void kernel_launch(void* const* d_in, const int* in_sizes, int n_in, void* d_out, int out_size, void* d_ws, size_t ws_size, hipStream_t stream) {
    static int grid = 0;
    if (grid == 0) {
        if (n_in != 38 || (size_t)out_size != OUT_END || ws_size < WS_END) { fprintf(stderr, "kernel_launch: unexpected shapes (n_in %d, out %d, ws %zu); nothing launched\n", n_in, out_size, ws_size); grid = -1; return; }
        int dev = 0, cus = 0, per_cu = 0;
        if (hipGetDevice(&dev) != hipSuccess || hipDeviceGetAttribute(&cus, hipDeviceAttributeMultiprocessorCount, dev) != hipSuccess) { grid = -1; return; }
        if (hipFuncSetAttribute((const void*)trunk_fwd, hipFuncAttributeMaxDynamicSharedMemorySize, LDS_BYTES) != hipSuccess) { fprintf(stderr, "kernel_launch: hipFuncSetAttribute failed\n"); grid = -1; return; }
        if (hipOccupancyMaxActiveBlocksPerMultiprocessor(&per_cu, (const void*)trunk_fwd, NTHR, LDS_BYTES) != hipSuccess || per_cu < 1) { fprintf(stderr, "kernel_launch: occupancy query says %d\n", per_cu); (void)hipGetLastError(); per_cu = 1; }
        grid = cus;
    }
    if (grid < 0) return;
    (void)hipMemsetAsync((char*)d_ws + WS_CTL, 0, CTL_ZERO_BYTES, stream);
    Args a{};
    for (int i = 0; i < 38; ++i) a.in[i] = (const float*)d_in[i];
    a.out = (float*)d_out; a.ws = (unsigned char*)d_ws;
#if MK_PER_PHASE
    for (int p = 0; p < N_PHASES; ++p) { a.ph_lo = p; a.ph_hi = p + 1; hipLaunchKernelGGL(trunk_fwd, dim3(grid), dim3(NTHR), LDS_BYTES, stream, a); }
#else
    a.ph_lo = 0; a.ph_hi = N_PHASES;
    hipLaunchKernelGGL(trunk_fwd, dim3(grid), dim3(NTHR), LDS_BYTES, stream, a);
#endif
}
```

```cpp
#include <hip/hip_runtime.h>
#include <cstdio>
#include <cstdint>
namespace pg8 {
#define PG8_LAS __attribute__((address_space(3)))
typedef unsigned short bf16_t;
typedef short bf16x8 __attribute__((ext_vector_type(8)));
typedef float f32x4 __attribute__((ext_vector_type(4)));
typedef unsigned u32x4 __attribute__((ext_vector_type(4)));
constexpr int BM = 256, BK = 64, HALF = 128, HTB = HALF * BK * 2  , STAGE_BYTES = 8 * HTB, NXCD = 8, WGM = 8;

__host__ __device__ __forceinline__ int lds_byte(int r, int c) { const int st = (r >> 4) * 2 + (c >> 5), rr = r & 15, cc = c & 31, ob = rr * 64 + cc * 2; return st * 1024 + (ob ^ (((ob >> 9) & 1) << 5)); }
__host__ __device__ __forceinline__ void stage_rc(int b, int& R, int& C) { const int st = b / 1024, sb = b % 1024, swz = sb ^ (((sb >> 9) & 1) << 5); R = (st >> 1) * 16 + swz / 64; C = (st & 1) * 32 + (swz % 64) / 2; }
__host__ __device__ __forceinline__ int perm32(int rho) { const int n = rho >> 4, i = rho & 15; return 8 * (i >> 2) + 4 * n + (i & 3); }

struct Unit { int pm, pn; };
struct Gemm { const bf16_t* A; const bf16_t* Bt; int M, N, K, lda, rowperm, ks_sh, ks_msk; };

struct StaticOrder {
    int nM, nN, nwg, G, c;
    __host__ __device__ void init(int M, int N, int G_, int c_) { nM = M / BM; nN = N / BM; nwg = nM * nN; G = G_; c = c_; }
    __host__ __device__ bool next(int i, Unit& u) const {
        const long L = (long)i * G + c; if (L >= nwg) return false;
        int wgid = (int)L; { const int q = nwg / NXCD, r = nwg % NXCD, xcd = wgid % NXCD, off = wgid / NXCD; wgid = (xcd < r ? xcd * (q + 1) : r * (q + 1) + (xcd - r) * q) + off; }
        const int nig = WGM * nN, gid = wgid / nig, fm = gid * WGM, gsz = (nM - fm) < WGM ? (nM - fm) : WGM;
        u.pm = fm + ((wgid % nig) % gsz); u.pn = (wgid % nig) / gsz; return true;
    }
    __device__ __forceinline__ void a_ready(const Unit&) const {}
    __device__ __forceinline__ void done(const Unit&) const {}
};

__device__ __forceinline__ unsigned cvt_pk_bf16(float lo, float hi) { unsigned r; asm volatile("v_cvt_pk_bf16_f32 %0, %1, %2" : "=v"(r) : "v"(lo), "v"(hi)); return r; }
__device__ __forceinline__ float fsigmoid(float x) { return __builtin_amdgcn_rcpf(1.0f + __expf(-x)); }
__device__ __forceinline__ float ftanh(float x) { return 1.0f - 2.0f * __builtin_amdgcn_rcpf(1.0f + __expf(2.0f * x)); }
__device__ __forceinline__ float bf_lo(unsigned w) { return __uint_as_float(w << 16); }
__device__ __forceinline__ float bf_hi(unsigned w) { return __uint_as_float(w & 0xffff0000u); }

constexpr int PP = 3712;
enum EpiKind { K_PROJ = 0, K_LORA = 1, K_PLAIN = 2, K_GATES = 3, K_RESID = 4, K_GUACT = 5 };
constexpr int XCH_OFF = 131072 + 8192;
struct EpiAny {
    static constexpr bool AFTER_DRAIN = false;
    int kind, ldc; bf16_t* O; const float* f0; const float* f1; const float* f2; const bf16_t* U; float* xout;
    __device__ __forceinline__ bool perm() const { return kind != K_RESID; }
    __device__ __forceinline__ void operator()(const f32x4 (&acc)[2][2][4][2], const Unit& u, int wr, int wc, int fr, int fq, PG8_LAS unsigned char* lds) const {
        const int row0 = u.pm * BM + wr * 64 + fr;
        if (kind == K_GUACT) {
            const bool ctx = u.pm < 32;
            const int cb0 = u.pn * HALF + wc * 32 + 8 * fq;
            PG8_LAS float* xch = (PG8_LAS float*)(lds + XCH_OFF);
            if (fr == (wr == 0 ? 15 : 0)) {
#pragma unroll
                for (int n = 0; n < 2; ++n)
#pragma unroll
                    for (int j = 0; j < 4; ++j) xch[((wr * 4 + wc) * 4 + fq) * 8 + 4 * n + j] = wr == 0 ? acc[1][0][3][n][j] : acc[0][0][0][n][j];
            }
            asm volatile("s_waitcnt lgkmcnt(0)" ::: "memory"); __builtin_amdgcn_s_barrier(); asm volatile("" ::: "memory");
            const size_t tok0 = (size_t)u.pm * BM + 128 * wr + 8 * fr;
#pragma unroll
            for (int n = 0; n < 2; ++n) {
                const f32x4 w0 = *(const f32x4*)(f0 + cb0 + 4 * n), w1 = *(const f32x4*)(f0 + 2816 + cb0 + 4 * n), w2 = *(const f32x4*)(f0 + 2 * 2816 + cb0 + 4 * n), bs = *(const f32x4*)(f1 + cb0 + 4 * n);
                const f32x4 xo = *(const PG8_LAS f32x4*)(xch + (((1 - wr) * 4 + wc) * 4 + fq) * 8 + 4 * n);
                float res[8][4];
#pragma unroll
                for (int j = 0; j < 4; ++j) {
                    float g[8];
#pragma unroll
                    for (int i = 0; i < 8; ++i) g[i] = acc[i >> 2][0][i & 3][n][j];
                    float left = __builtin_bit_cast(float, __builtin_amdgcn_update_dpp(0, __builtin_bit_cast(int, g[7]), 0x111, 0xf, 0xf, true));
                    float right = __builtin_bit_cast(float, __builtin_amdgcn_update_dpp(0, __builtin_bit_cast(int, g[0]), 0x101, 0xf, 0xf, true));
                    if (ctx) { if (wr == 1 && fr == 0) left = xo[j]; if (wr == 0 && fr == 15) right = xo[j]; }
                    else { if ((fr & 7) == 0) left = 0.f; if ((fr & 7) == 7) right = 0.f; }
#pragma unroll
                    for (int i = 0; i < 8; ++i) { const float gm = i == 0 ? left : g[i - 1], gp_ = i == 7 ? right : g[i + 1];
                        const float c = bs[j] + w0[j] * gm + w1[j] * g[i] + w2[j] * gp_;
                        res[i][j] = c * fsigmoid(c) * acc[i >> 2][1][i & 3][n][j]; }
                }
#pragma unroll
                for (int i = 0; i < 8; ++i) { uint2 w; w.x = cvt_pk_bf16(res[i][0], res[i][1]); w.y = cvt_pk_bf16(res[i][2], res[i][3]);
                    *(uint2*)(O + (tok0 + i) * 2816 + cb0 + 4 * n) = w; }
            }
        } else if (kind == K_RESID) {
            const int col0 = u.pn * BM + wc * 32 + 4 * fq;
            const int slot = u.pm < 32 ? 0 : 1 + ((u.pm - 32) >> 3);
            const float* src = u.pm < 32 ? f0 : f1 - (size_t)8192 * 1024;
            const float* gp = f2 + (size_t)slot * 6144;
#pragma unroll
            for (int bj = 0; bj < 2; ++bj)
#pragma unroll
                for (int n = 0; n < 2; ++n) { const f32x4 gv = *(const f32x4*)(gp + col0 + bj * HALF + n * 16);
                    f32x4 xs[2][4];
#pragma unroll
                    for (int ai = 0; ai < 2; ++ai)
#pragma unroll
                        for (int m = 0; m < 4; ++m) xs[ai][m] = *(const f32x4*)(src + (size_t)(row0 + ai * HALF + m * 16) * 1024 + col0 + bj * HALF + n * 16);
                    asm volatile("" ::: "memory");
#pragma unroll
                    for (int ai = 0; ai < 2; ++ai)
#pragma unroll
                        for (int m = 0; m < 4; ++m) *(f32x4*)(xout + (size_t)(row0 + ai * HALF + m * 16) * 1024 + col0 + bj * HALF + n * 16) = xs[ai][m] + gv * acc[ai][bj][m][n];
                    asm volatile("" ::: "memory"); }
        } else if (kind == K_GATES) {
            const int d = u.pn >> 1, ch0 = (u.pn & 1) * HALF + wc * 32 + 8 * fq;
#pragma unroll
            for (int n = 0; n < 2; ++n) {
                const f32x4 bav = *(const f32x4*)(f0 + d * 256 + ch0 + 4 * n), bxv = *(const f32x4*)(f1 + d * 256 + ch0 + 4 * n), spv = *(const f32x4*)(f2 + d * 256 + ch0 + 4 * n);
#pragma unroll
                for (int ai = 0; ai < 2; ++ai)
#pragma unroll
                    for (int m = 0; m < 4; ++m) {
                        const size_t row = (size_t)(row0 + ai * HALF + m * 16);
                        const uint2 uu = *(const uint2*)(U + row * 256 + ch0 + 4 * n);
                        const float uv[4] = {bf_lo(uu.x), bf_hi(uu.x), bf_lo(uu.y), bf_hi(uu.y)};
                        float la2[4], bb[4];
#pragma unroll
                        for (int j = 0; j < 4; ++j) {
                            const float rg = fsigmoid(acc[ai][0][m][n][j] + bav[j]), ig = fsigmoid(acc[ai][1][m][n][j] + bxv[j]);
                            const float la = -8.0f * rg * spv[j];
                            la2[j] = la * 1.44269504089f; bb[j] = sqrtf(-expm1f(2.0f * la)) * ig * uv[j]; }
                        uint2 w0; w0.x = cvt_pk_bf16(la2[0], la2[1]); w0.y = cvt_pk_bf16(la2[2], la2[3]);
                        uint2 w1; w1.x = cvt_pk_bf16(bb[0], bb[1]); w1.y = cvt_pk_bf16(bb[2], bb[3]);
                        *(uint2*)(O + row * 1024 + d * 512 + ch0 + 4 * n) = w0;
                        *(uint2*)(O + row * 1024 + d * 512 + 256 + ch0 + 4 * n) = w1;
                        asm volatile("" ::: "memory");
                    }
            }
        } else {
            const int col0 = u.pn * BM + wc * 32 + 8 * fq;
#pragma unroll
            for (int bj = 0; bj < 2; ++bj) {
                int act = 0; float sc = 1.0f; f32x4 b0 = (f32x4){0.f, 0.f, 0.f, 0.f}, b1 = b0;
                if (kind == K_PROJ) { if (u.pn == 14 && bj == 1) continue; act = (u.pn == 6 && bj == 0) ? 1 : ((u.pn == 7 && bj == 0) ? 2 : 0); }
                if (kind == K_LORA) { const int grp = u.pn >> 1, cc = (col0 + bj * HALF) & 1023;
                    if (grp < 4) { const float* bp = (grp < 2 ? f0 : f1) + cc; b0 = *(const f32x4*)bp; b1 = *(const f32x4*)(bp + 4); act = 2; sc = grp < 2 ? 0.60653065971f : 1.0f; } }
#pragma unroll
                for (int ai = 0; ai < 2; ++ai)
#pragma unroll
                    for (int m = 0; m < 4; ++m) {
                        f32x4 v0 = acc[ai][bj][m][0] + b0, v1 = acc[ai][bj][m][1] + b1;
                        if (act == 1) {
#pragma unroll
                            for (int j = 0; j < 4; ++j) { v0[j] = ftanh(v0[j]); v1[j] = ftanh(v1[j]); } }
                        if (act == 2) {
#pragma unroll
                            for (int j = 0; j < 4; ++j) { v0[j] = fsigmoid(v0[j]) * sc; v1[j] = fsigmoid(v1[j]) * sc; } }
                        u32x4 w; w.x = cvt_pk_bf16(v0[0], v0[1]); w.y = cvt_pk_bf16(v0[2], v0[3]); w.z = cvt_pk_bf16(v1[0], v1[1]); w.w = cvt_pk_bf16(v1[2], v1[3]);
                        *(u32x4*)(O + (size_t)(row0 + ai * HALF + m * 16) * ldc + col0 + bj * HALF) = w;
                    }
            }
        }
    }
};
template <class Epi, class Sched, bool ALIGN_EPI = false, bool SP2 = false>
__device__ __forceinline__ void gemm_phase(PG8_LAS unsigned char* lds, const Gemm g, const Sched& S, const Epi& E) {
    int tid_ = threadIdx.x; asm volatile("" : "+v"(tid_));
    const int tid = tid_, wid = __builtin_amdgcn_readfirstlane(tid >> 6), lane = tid & 63, wr = wid >> 2, wc = wid & 3, fr = lane & 15, fq = lane >> 4;
    const int K = g.K, nt = K / BK;
    unsigned voffA[2], voffB[2];
    {
        const int b0 = tid * 16, st = b0 >> 10, sb = b0 & 1023, swz = sb ^ (((sb >> 9) & 1) << 5);
        const int R0 = (st >> 1) * 16 + (swz >> 6), C0 = (st & 1) * 32 + ((swz & 63) >> 1);
        const int Rb = E.perm() ? ((R0 & ~31) + perm32(R0 & 31)) : R0;
        const int Rt = g.rowperm ? (8 * (R0 & 15) + ((R0 >> 4) & 3)) : R0;
        voffA[0] = (unsigned)(Rt * g.lda + C0) * 2u; voffA[1] = voffA[0] + (unsigned)((g.rowperm ? 128 : 64) * g.lda) * 2u;
        voffB[0] = (unsigned)(Rb * K + C0) * 2u; voffB[1] = voffB[0] + (unsigned)(64 * K) * 2u;
    }
    const size_t kstep = (size_t)(BK * 2);
    const size_t hsA = (size_t)(g.rowperm ? 4 : HALF) * g.lda * 2, hsB = (size_t)HALF * K * 2;
    const size_t tsA = (size_t)BM * g.lda * 2, tsB = 2 * hsB;
    const unsigned ldsw = (unsigned)wid * 1024u;
    const int aoff = lds_byte(wr * 64 + fr, fq * 8), boff = lds_byte(wc * 32 + fr, fq * 8);
#define PG8_SA(b, h) (((b) * 2 + (h)) * HTB)
#define PG8_SB(b, h) ((4 + (b) * 2 + (h)) * HTB)
#define PG8_STAGE(bufoff, gbase, voff) do { _Pragma("unroll") for (int _i = 0; _i < 2; ++_i) \
        __builtin_amdgcn_global_load_lds((const unsigned*)((const char*)(gbase) + (voff)[_i]), (PG8_LAS unsigned*)(lds + (bufoff) + ldsw + _i * 8192), 16, 0, 0); } while (0)
#define PG8_LDA(dst, b, h) do { _Pragma("unroll") for (int m = 0; m < 4; ++m) _Pragma("unroll") for (int k = 0; k < 2; ++k) dst[m][k] = *(const PG8_LAS bf16x8*)(lds + PG8_SA(b, h) + aoff + m * 2048 + k * 1024); } while (0)
#define PG8_LDB(dst, b, h) do { _Pragma("unroll") for (int n = 0; n < 2; ++n) _Pragma("unroll") for (int k = 0; k < 2; ++k) dst[n][k] = *(const PG8_LAS bf16x8*)(lds + PG8_SB(b, h) + boff + n * 2048 + k * 1024); } while (0)
#define PG8_MMA(ai, bj, At, Bt) do { __builtin_amdgcn_s_setprio(1); _Pragma("unroll") for (int m = 0; m < 4; ++m) _Pragma("unroll") for (int n = 0; n < 2; ++n) _Pragma("unroll") for (int k = 0; k < 2; ++k) \
        acc[ai][bj][m][n] = __builtin_amdgcn_mfma_f32_16x16x32_bf16(Bt[n][k], At[m][k], acc[ai][bj][m][n], 0, 0, 0); __builtin_amdgcn_s_setprio(0); } while (0)
#define PG8_WAIT_V(n) asm volatile("s_waitcnt vmcnt(" #n ")" ::: "memory")
#define PG8_WAIT_L(n) asm volatile("s_waitcnt lgkmcnt(" #n ")" ::: "memory")
#define PG8_BAR __builtin_amdgcn_s_barrier()
#define PG8_SCHED __builtin_amdgcn_sched_barrier(0)
    Unit cur, nxt; int ui = 0;
    if (!S.next(0, cur)) return;
    f32x4 acc[2][2][4][2];
#pragma unroll
    for (int a = 0; a < 2; ++a)
#pragma unroll
        for (int b = 0; b < 2; ++b)
#pragma unroll
            for (int m = 0; m < 4; ++m)
#pragma unroll
                for (int n = 0; n < 2; ++n) acc[a][b][m][n] = (f32x4){0.f, 0.f, 0.f, 0.f};
    bf16x8 At[4][2], B0[2][2], B1[2][2];
    const char* cA = (const char*)g.A + (size_t)cur.pm * tsA + (size_t)((cur.pn >> g.ks_sh) & g.ks_msk) * 256;     const char* cB = (const char*)g.Bt + (size_t)cur.pn * tsB;
    S.a_ready(cur);
    if constexpr (SP2) {
        PG8_STAGE(PG8_SB(0, 0), cB, voffB); PG8_STAGE(PG8_SB(0, 1), cB + hsB, voffB); PG8_STAGE(PG8_SA(0, 0), cA, voffA); PG8_STAGE(PG8_SA(0, 1), cA + hsA, voffA);
        if (wr == 1) PG8_BAR;
        PG8_WAIT_V(2); PG8_BAR;
        PG8_STAGE(PG8_SB(1, 0), cB + kstep, voffB); PG8_STAGE(PG8_SA(1, 0), cA + kstep, voffA); PG8_STAGE(PG8_SB(1, 1), cB + hsB + kstep, voffB);
        PG8_WAIT_V(6); PG8_BAR;
    } else {
        PG8_STAGE(PG8_SB(0, 0), cB, voffB); PG8_STAGE(PG8_SA(0, 0), cA, voffA); PG8_STAGE(PG8_SB(0, 1), cB + hsB, voffB); PG8_STAGE(PG8_SA(0, 1), cA + hsA, voffA);
        if (wr == 1) PG8_BAR;
        PG8_WAIT_V(4); PG8_BAR;
        PG8_STAGE(PG8_SB(1, 0), cB + kstep, voffB); PG8_STAGE(PG8_SA(1, 0), cA + kstep, voffA); PG8_STAGE(PG8_SB(1, 1), cB + hsB + kstep, voffB);
        PG8_WAIT_V(6); PG8_BAR;
    }
    for (;;) {
        const bool has_next = S.next(ui + 1, nxt);
        const char* nA = has_next ? (const char*)g.A + (size_t)nxt.pm * tsA + (size_t)((nxt.pn >> g.ks_sh) & g.ks_msk) * 256 : cA; const char* nB = has_next ? (const char*)g.Bt + (size_t)nxt.pn * tsB : cB;
        for (int t = 0; t < nt; t += 2) {
            const bool last = (t == nt - 2);
            const char* a1 = cA + (size_t)(t + 1) * kstep;
            const char* a2 = last ? nA : cA + (size_t)(t + 2) * kstep; const char* b2 = last ? nB : cB + (size_t)(t + 2) * kstep;
            const char* a3 = a2 + kstep; const char* b3 = b2 + kstep;
            if (last && has_next) S.a_ready(nxt);
            if constexpr (SP2) {
            PG8_LDB(B0, 0, 0); PG8_LDB(B1, 0, 1); PG8_SCHED; PG8_LDA(At, 0, 0); PG8_STAGE(PG8_SA(1, 1), a1 + hsA, voffA);
            PG8_WAIT_V(8); PG8_WAIT_L(0); PG8_BAR; PG8_MMA(0, 0, At, B0); PG8_MMA(0, 1, At, B1); PG8_BAR; PG8_SCHED;
            PG8_LDA(At, 0, 1); PG8_STAGE(PG8_SB(0, 0), b2, voffB); PG8_STAGE(PG8_SB(0, 1), b2 + hsB, voffB); PG8_STAGE(PG8_SA(0, 0), a2, voffA);
            PG8_WAIT_V(8); PG8_WAIT_L(0); PG8_BAR; PG8_MMA(1, 0, At, B0); PG8_MMA(1, 1, At, B1); PG8_BAR; PG8_SCHED;
            PG8_LDB(B0, 1, 0); PG8_LDB(B1, 1, 1); PG8_SCHED; PG8_LDA(At, 1, 0); PG8_STAGE(PG8_SA(0, 1), a2 + hsA, voffA);
            PG8_WAIT_V(8); PG8_WAIT_L(0); PG8_BAR; PG8_MMA(0, 0, At, B0); PG8_MMA(0, 1, At, B1); PG8_BAR; PG8_SCHED;
            PG8_LDA(At, 1, 1); PG8_STAGE(PG8_SB(1, 0), b3, voffB); PG8_STAGE(PG8_SB(1, 1), b3 + hsB, voffB); PG8_STAGE(PG8_SA(1, 0), a3, voffA);
            PG8_WAIT_V(8); PG8_WAIT_L(0); PG8_BAR; PG8_MMA(1, 0, At, B0); PG8_MMA(1, 1, At, B1); PG8_BAR; PG8_SCHED;
            } else {
            PG8_LDB(B0, 0, 0); PG8_SCHED; PG8_LDA(At, 0, 0); PG8_STAGE(PG8_SA(1, 1), a1 + hsA, voffA);
            PG8_WAIT_L(8); PG8_BAR; PG8_WAIT_L(0); PG8_MMA(0, 0, At, B0); PG8_BAR; PG8_SCHED;
            PG8_LDB(B1, 0, 1); PG8_STAGE(PG8_SB(0, 0), b2, voffB);
            PG8_BAR; PG8_WAIT_L(0); PG8_MMA(0, 1, At, B1); PG8_BAR;
            PG8_LDA(At, 0, 1); PG8_STAGE(PG8_SA(0, 0), a2, voffA);
            PG8_BAR; PG8_WAIT_L(0); PG8_MMA(1, 0, At, B0); PG8_BAR; PG8_SCHED;
            PG8_STAGE(PG8_SB(0, 1), b2 + hsB, voffB);
            PG8_WAIT_V(6); PG8_BAR; PG8_MMA(1, 1, At, B1); PG8_BAR;
            PG8_LDB(B0, 1, 0); PG8_SCHED; PG8_LDA(At, 1, 0); PG8_STAGE(PG8_SA(0, 1), a2 + hsA, voffA);
            PG8_WAIT_L(8); PG8_BAR; PG8_WAIT_L(0); PG8_MMA(0, 0, At, B0); PG8_BAR; PG8_SCHED;
            PG8_LDB(B1, 1, 1); PG8_STAGE(PG8_SB(1, 0), b3, voffB);
            PG8_BAR; PG8_WAIT_L(0); PG8_MMA(0, 1, At, B1); PG8_BAR;
            PG8_LDA(At, 1, 1); PG8_STAGE(PG8_SA(1, 0), a3, voffA);
            PG8_BAR; PG8_WAIT_L(0); PG8_MMA(1, 0, At, B0); PG8_BAR; PG8_SCHED;
            PG8_STAGE(PG8_SB(1, 1), b3 + hsB, voffB);
            PG8_WAIT_V(6); PG8_BAR; PG8_MMA(1, 1, At, B1); PG8_BAR;
            }
        }
        if constexpr (ALIGN_EPI) { if (wr == 0) PG8_BAR; }
        if constexpr (!Epi::AFTER_DRAIN) { E(acc, cur, wr, wc, fr, fq, lds); S.done(cur); }
        if (!has_next) break;
#pragma unroll
        for (int a = 0; a < 2; ++a)
#pragma unroll
            for (int b = 0; b < 2; ++b)
#pragma unroll
                for (int m = 0; m < 4; ++m)
#pragma unroll
                    for (int n = 0; n < 2; ++n) acc[a][b][m][n] = (f32x4){0.f, 0.f, 0.f, 0.f};
        cur = nxt; cA = nA; cB = nB; ++ui;
        if constexpr (ALIGN_EPI) { if (wr == 1) PG8_BAR; }
    }
    PG8_WAIT_V(0);
    if constexpr (!ALIGN_EPI) { if (wr == 0) PG8_BAR; }
    PG8_BAR;
    if constexpr (Epi::AFTER_DRAIN) { E.fused(acc, cur, wr, wc, fr, fq, lds, wid, lane); S.done(cur); }
#undef PG8_SA
#undef PG8_SB
#undef PG8_STAGE
#undef PG8_LDA
#undef PG8_LDB
#undef PG8_MMA
#undef PG8_WAIT_V
#undef PG8_WAIT_L
#undef PG8_BAR
#undef PG8_SCHED
}
}

using pg8::PP;
constexpr int NWAVES = 8, NTHR = 512;
constexpr int D = 1024, MTOK = 16384, MCTX = 8192, NB_CTX = 32, T_CTX = 256, NB_LAT = 4, T_LAT = 2048, NSLOT = 5;
constexpr int DFF = 2816, NPROJ = 3840, NLORA = 2560, KLORA = 128, NGATE = 1024, KGATE = 128, NGU = 5632;
constexpr int C_R = 0, C_K = 512, C_V = 1024, C_LORA = 1536, C_XB = 1920, C_GB = 2176, C_Q = 2432, C_FF = 2688, C_IV = 3200, C_OG = 3456;
constexpr size_t OUT_Y = 0, OUT_RWKV = (size_t)MTOK * D, OUT_LRU = OUT_RWKV + (size_t)32 * 2 * 2 * 8 * 4096, OUT_HGRN = OUT_LRU + (size_t)32 * 2 * 2 * 256, OUT_END = OUT_HGRN + (size_t)32 * 2 * 2 * 4 * 4096;
constexpr size_t MiB = 1u << 20;
constexpr size_t WS_CTL = 0, CTL_ZERO_BYTES = 64 * 1024;
constexpr size_t WS_MODP = 1 * MiB;
constexpr size_t WS_MOD = 3 * MiB;
constexpr size_t WS_SP = WS_MOD + 256 * 1024;
constexpr size_t WS_W = 4 * MiB;
constexpr size_t W_IN = 0, W_OUT = W_IN + (size_t)NPROJ * D * 2, W_GU = W_OUT + (size_t)D * D * 2, W_DOWN = W_GU + (size_t)NGU * D * 2,
                 W_LORA = W_DOWN + (size_t)D * DFF * 2, W_GATE = W_LORA + (size_t)NLORA * KLORA * 2, W_END = W_GATE + (size_t)NGATE * KGATE * 2;
static_assert(WS_W + W_END <= 34 * MiB, "weights");
constexpr size_t WS_R1 = 34 * MiB;
constexpr size_t WS_P = 66 * MiB;
constexpr size_t WS_L = 182 * MiB;
constexpr size_t WS_U = 262 * MiB;
constexpr size_t WS_G = 270 * MiB;
constexpr size_t WS_OR = 302 * MiB;
constexpr size_t WS_OH = 334 * MiB;
constexpr size_t WS_GU = 66 * MiB;
constexpr size_t WS_ACT = 242 * MiB;
constexpr size_t WS_END = 350 * MiB;
static_assert(WS_P + (size_t)MTOK * PP * 2 <= WS_L && WS_L + (size_t)MTOK * NLORA * 2 <= WS_U && WS_OH + (size_t)2 * MTOK * 256 * 2 <= WS_END && WS_GU + (size_t)MTOK * NGU * 2 <= WS_ACT && WS_ACT + (size_t)MTOK * DFF * 2 <= WS_END, "d_ws map");
constexpr int CW_BAR = 1024;
constexpr int CW_QUEUE = 8192;
static_assert((CW_QUEUE + 512) * 4 <= (int)CTL_ZERO_BYTES && CW_BAR + 3456 <= CW_QUEUE, "ctl");
constexpr int RING_OFF = 0, RING_BYTES = 131072;
constexpr int LDSCTL_OFF = RING_BYTES, MISC_OFF = LDSCTL_OFF + 320, PTBL_OFF = LDSCTL_OFF + 512, JDESC_OFF = LDSCTL_OFF + 1024;
constexpr int LDS_BYTES = 147456;

#define GAS __attribute__((address_space(1)))
#define LAS __attribute__((address_space(3)))
typedef unsigned short bf16;
typedef unsigned v4u __attribute__((ext_vector_type(4)));
typedef unsigned v2u __attribute__((ext_vector_type(2)));
typedef float f32x4 __attribute__((ext_vector_type(4)));
typedef float f32x2 __attribute__((ext_vector_type(2)));
typedef GAS unsigned gu32;
#define RLX_AGENT __ATOMIC_RELAXED, __HIP_MEMORY_SCOPE_AGENT
#define LDS_WAIT() asm volatile("s_waitcnt lgkmcnt(0)" ::: "memory")
#define VM_WAIT() asm volatile("s_waitcnt vmcnt(0)" ::: "memory")
using pg8::cvt_pk_bf16; using pg8::fsigmoid; using pg8::ftanh; using pg8::bf_lo; using pg8::bf_hi;
__device__ __forceinline__ float bf2f(bf16 h) { return __uint_as_float((unsigned)h << 16); }
__device__ __forceinline__ bf16 f2bf(float f) { return (bf16)(cvt_pk_bf16(f, 0.f) & 0xffffu); }
template <int CTRL> __device__ __forceinline__ float dpp_mov(float v) { return __builtin_bit_cast(float, __builtin_amdgcn_update_dpp(0, __builtin_bit_cast(int, v), CTRL, 0xf, 0xf, true)); }
__device__ __forceinline__ float rowsum16(float v) { v += dpp_mov<0xB1>(v); v += dpp_mov<0x4E>(v); v += dpp_mov<0x141>(v); v += dpp_mov<0x140>(v); return v; }
__device__ __forceinline__ float wave_sum(float v) {
#pragma unroll
    for (int o = 1; o < 64; o <<= 1) v += __shfl_xor(v, o);
    return v;
}
#define XB_TMO      128
#define XB_XCNT(j)  (256  + 64 * (j))
#define XB_XSUB(j)  (1280 + 64 * (j))
#define XB_XGEN(j)  (2304 + 64 * (j))
#define XB_TOP      3328
#define XB_TOPGEN   3392
#define XCD_BAR_WORDS 3456
#define XB_SPIN_CAP (1u << 18)

__device__ __forceinline__ unsigned xb_ld(unsigned* p)              { return __hip_atomic_load(p, __ATOMIC_RELAXED, __HIP_MEMORY_SCOPE_AGENT); }
__device__ __forceinline__ unsigned xb_add(unsigned* p, unsigned v) { return __hip_atomic_fetch_add(p, v, __ATOMIC_RELAXED, __HIP_MEMORY_SCOPE_AGENT); }
__device__ __forceinline__ unsigned xb_xcc_id() { return (unsigned)__builtin_amdgcn_s_getreg((3 << 11) | 20) & 0xFu; }
#define XB_SPIN(cond, bar) do { unsigned _sp = 0; while (cond) { __builtin_amdgcn_s_sleep(1); \
    if ((++_sp & 255u) == 0u) { if (xb_ld(&(bar)[XB_TMO])) break; if (_sp > XB_SPIN_CAP) { atomicAdd(&(bar)[XB_TMO], 1u); break; } } } } while (0)

struct XcdBarrier {
    unsigned* bar; unsigned x;
    volatile LAS unsigned* st;
};

__device__ __forceinline__ XcdBarrier xcd_barrier_post(unsigned* bar, volatile LAS unsigned* st) {
    XcdBarrier b; b.bar = bar; b.x = xb_xcc_id(); b.st = st;
    if (threadIdx.x == 0) (void)xb_add(&bar[XB_XCNT(b.x)], 1u);
    return b;
}
__device__ __forceinline__ void xcd_barrier_complete(unsigned* bar, unsigned x, unsigned& nloc, unsigned& nx) {
    const unsigned G = gridDim.x * gridDim.y * gridDim.z;
    unsigned sum, cnt, mine, sp = 0u;
    for (;;) {
        sum = 0u; cnt = 0u; mine = 0u;
#pragma unroll
        for (unsigned j = 0; j < 16; ++j) { const unsigned c = xb_ld(&bar[XB_XCNT(j)]); sum += c; cnt += (c > 0u) ? 1u : 0u; mine = (j == x) ? c : mine; }
        if (sum == G) break;
        __builtin_amdgcn_s_sleep(1);
        if ((++sp & 255u) == 0u) { if (xb_ld(&bar[XB_TMO])) break; if (sp > XB_SPIN_CAP) { atomicAdd(&bar[XB_TMO], 1u); break; } }
    }
    nloc = mine > 0u ? mine : 1u; nx = cnt > 0u ? cnt : 1u;
}

__device__ __forceinline__ void xcd_barrier(const XcdBarrier& b) {
    asm volatile("s_waitcnt vmcnt(0)" ::: "memory");
    __syncthreads();
    if (threadIdx.x == 0) {
        unsigned* bar = b.bar;
        __builtin_amdgcn_s_waitcnt(0);
        unsigned nloc = b.st[0], nx = b.st[1];
        if (nloc == 0u) { xcd_barrier_complete(bar, b.x, nloc, nx); b.st[0] = nloc; b.st[1] = nx; }
        const unsigned old = xb_add(&bar[XB_XSUB(b.x)], 1u);
        const unsigned gen = old / nloc;
        if (old + 1u == (gen + 1u) * nloc) {
            __builtin_amdgcn_fence(__ATOMIC_RELEASE, "agent");
            asm volatile("s_waitcnt vmcnt(0)" ::: "memory");
            const unsigned og = xb_add(&bar[XB_TOP], 1u);
            const unsigned tg = og / nx;
            if (og + 1u == (tg + 1u) * nx) xb_add(&bar[XB_TOPGEN], 1u);
            else XB_SPIN(xb_ld(&bar[XB_TOPGEN]) == tg, bar);
            __builtin_amdgcn_fence(__ATOMIC_ACQUIRE, "agent");
            xb_add(&bar[XB_XGEN(b.x)], 1u);
            asm volatile("s_waitcnt vmcnt(0)" ::: "memory");
        } else {
            XB_SPIN(xb_ld(&bar[XB_XGEN(b.x)]) == gen, bar);
            __builtin_amdgcn_fence(__ATOMIC_ACQUIRE, "agent");
            asm volatile("s_waitcnt vmcnt(0)" ::: "memory");
        }
    }
    __syncthreads();
}


struct Args { const float* in[38]; float* out; unsigned char* ws; int ph_lo, ph_hi; };
enum InIdx { I_XP = 0, I_XS, I_SRWKV, I_SLRU, I_SHGRN, I_C, I_CCTX, I_ADAW, I_ADAB, I_NMIXG, I_NFFNG, I_WIN, I_WOUT, I_W0, I_WUP, I_A0, I_AUP, I_GUP, I_KK, I_KA, I_RK, I_LNW, I_LNB,
             I_LCW, I_LCB, I_LWA, I_LBA, I_LWX, I_LBX, I_LLAM, I_HLB, I_HNG, I_FWG, I_FWU, I_FCW, I_FCB, I_FWD, I_FING };

struct InTbl { const LAS unsigned long long* t;
    __device__ __forceinline__ const float* operator[](int i) const { const unsigned long long v = t[i];
        const unsigned lo = __builtin_amdgcn_readfirstlane((unsigned)v), hi = __builtin_amdgcn_readfirstlane((unsigned)(v >> 32)); return (const float*)(const __attribute__((address_space(1))) float*)(((unsigned long long)hi << 32) | lo); } };
struct Ctx { InTbl in; float* out; unsigned char* ws; };
__device__ __forceinline__ int slot_of_row(int r) { return r < MCTX ? 0 : 1 + ((r - MCTX) >> 11); }

__device__ __forceinline__ void transpose_item(const float* W, int K, int N, bf16* WT, int item, int drow_mode, LAS float* scr, int lane) {
    const int nblk = N / 32, kb = item / nblk, nb = item % nblk, k0 = 64 * kb, n0 = 32 * nb;
    int drow0 = n0;
    if (drow_mode == 1) drow0 = (n0 >> 7) * 256 + (n0 & 127);
    if (drow_mode == 2) drow0 = (n0 >> 7) * 256 + 128 + (n0 & 127);
#pragma unroll 8
    for (int i = 0; i < 32; ++i) { const int kk = 2 * i + (lane >> 5); scr[kk * 33 + (lane & 31)] = W[(size_t)(k0 + kk) * N + n0 + (lane & 31)]; }
    LDS_WAIT();
    const int c = lane & 7;
#pragma unroll
    for (int j = 0; j < 4; ++j) { const int n = (lane >> 3) + 8 * j; const LAS float* s = scr + (8 * c) * 33 + n;
        v4u o; o.x = cvt_pk_bf16(s[0 * 33], s[1 * 33]); o.y = cvt_pk_bf16(s[2 * 33], s[3 * 33]); o.z = cvt_pk_bf16(s[4 * 33], s[5 * 33]); o.w = cvt_pk_bf16(s[6 * 33], s[7 * 33]);
        *(v4u*)(WT + (size_t)(drow0 + n) * K + k0 + 8 * c) = o; }
    LDS_WAIT();
}
__device__ __forceinline__ void convert_weights(const Ctx& a, int l, LAS unsigned char* lds, int gw, int NGW, int wave, int lane, int gtid, int NGT) {
    LAS float* scr = (LAS float*)(lds + wave * 8704);
    unsigned char* wb = a.ws + WS_W;
    constexpr int I_IN = (D / 64) * (PP / 32), I_OUT = (D / 64) * (D / 32), I_G = (D / 64) * (DFF / 32), I_DN = (DFF / 64) * (D / 32);
    constexpr int NITEMS = I_IN + I_OUT + 2 * I_G + I_DN;
    const float* p_win = a.in[I_WIN]; const float* p_wout = a.in[I_WOUT]; const float* p_fwg = a.in[I_FWG]; const float* p_fwu = a.in[I_FWU]; const float* p_fwd = a.in[I_FWD];
    for (int it = gw; it < NITEMS; it += NGW) {
        int r = it;
        if (r < I_IN) { transpose_item(p_win + (size_t)l * D * PP, D, PP, (bf16*)(wb + W_IN), r, 0, scr, lane); continue; } r -= I_IN;
        if (r < I_OUT) { transpose_item(p_wout + (size_t)l * D * D, D, D, (bf16*)(wb + W_OUT), r, 0, scr, lane); continue; } r -= I_OUT;
        if (r < I_G) { transpose_item(p_fwg + (size_t)l * D * DFF, D, DFF, (bf16*)(wb + W_GU), r, 1, scr, lane); continue; } r -= I_G;
        if (r < I_G) { transpose_item(p_fwu + (size_t)l * D * DFF, D, DFF, (bf16*)(wb + W_GU), r, 2, scr, lane); continue; } r -= I_G;
        transpose_item(p_fwd + (size_t)l * DFF * D, DFF, D, (bf16*)(wb + W_DOWN), r, 0, scr, lane);
    }
    constexpr int CH_Z = (NPROJ - PP) * D / 8, CH_L = NLORA * KLORA / 8, CH_G = NGATE * KGATE / 8;
    const float* wup = a.in[I_WUP] + (size_t)l * 2 * 64 * 512; const float* aup = a.in[I_AUP] + (size_t)l * 2 * 64 * 512; const float* gup = a.in[I_GUP] + (size_t)l * 128 * 512;
    const float* lwa = a.in[I_LWA] + (size_t)l * 2 * 4 * 64 * 64; const float* lwx = a.in[I_LWX] + (size_t)l * 2 * 4 * 64 * 64;
    for (int c = gtid; c < CH_Z + CH_L + CH_G; c += NGT) {
        float v[8];
#pragma unroll
        for (int j = 0; j < 8; ++j) v[j] = 0.f;
        bf16* dst;
        if (c < CH_Z) { dst = (bf16*)(wb + W_IN) + (size_t)PP * D + (size_t)c * 8; }
        else if (c < CH_Z + CH_L) {
            const int e = (c - CH_Z) * 8, n = e / KLORA, k0 = e % KLORA; dst = (bf16*)(wb + W_LORA) + e;
            const int grp = n >> 9, cc = n & 511;
            if (grp < 4) { if ((k0 >> 6) == (grp & 1)) { const float* src = (grp < 2 ? wup : aup) + (size_t)((grp & 1) * 64 + (k0 & 63)) * 512 + cc;
#pragma unroll
                    for (int j = 0; j < 8; ++j) v[j] = src[(size_t)j * 512]; } }
            else { const float* src = gup + (size_t)k0 * 512 + cc;
#pragma unroll
                    for (int j = 0; j < 8; ++j) v[j] = src[(size_t)j * 512]; }
        } else {
            const int e = (c - CH_Z - CH_L) * 8, n = e / KGATE, k0 = e % KGATE; dst = (bf16*)(wb + W_GATE) + e;
            const int pn = n >> 8, d = pn >> 1, ch = (pn & 1) * 128 + (n & 127), blk = ch >> 6, jj = ch & 63;
            if ((k0 >> 6) == (blk & 1)) { const float* src = (((n >> 7) & 1) ? lwx : lwa) + (size_t)(((d * 4 + blk) * 64 + (k0 & 63)) * 64) + jj;
#pragma unroll
                for (int j = 0; j < 8; ++j) v[j] = src[(size_t)j * 64]; }
        }
        v4u o; o.x = cvt_pk_bf16(v[0], v[1]); o.y = cvt_pk_bf16(v[2], v[3]); o.z = cvt_pk_bf16(v[4], v[5]); o.w = cvt_pk_bf16(v[6], v[7]);
        *(v4u*)dst = o;
    }
    if (gtid < 512) { const float lam = a.in[I_LLAM][l * 512 + gtid]; ((float*)(a.ws + WS_SP))[l * 512 + gtid] = log1pf(__expf(-lam)); }
}
__device__ __forceinline__ void mod_partials(const Ctx& a, LAS unsigned char* lds, int bid, int G, int tid) {
    LAS float* sc = (LAS float*)lds;
    const float* cctx = a.in[I_CCTX]; const float* cc = a.in[I_C]; const float* adaw = a.in[I_ADAW];
    for (int it = bid; it < 2 * 12 * 8; it += G) {
        const int l = it / 96, nb = (it % 96) / 8, ks = it % 8;
        __syncthreads();
        for (int e = tid; e < NSLOT * 128; e += NTHR) { const int s = e >> 7, k = ks * 128 + (e & 127);
            const float c = s == 0 ? cctx[k] : cc[(s - 1) * D + k]; sc[e] = c * fsigmoid(c); }
        __syncthreads();
        const int n = nb * 512 + tid; const float* wp = adaw + ((size_t)l * D + ks * 128) * 6144 + n;
        float acc[NSLOT];
#pragma unroll
        for (int s = 0; s < NSLOT; ++s) acc[s] = 0.f;
#pragma unroll 8
        for (int k = 0; k < 128; ++k) { const float w = wp[(size_t)k * 6144];
#pragma unroll
            for (int s = 0; s < NSLOT; ++s) acc[s] += sc[s * 128 + k] * w; }
        float* pp = (float*)(a.ws + WS_MODP) + ((size_t)(l * 8 + ks) * NSLOT) * 6144 + n;
#pragma unroll
        for (int s = 0; s < NSLOT; ++s) pp[(size_t)s * 6144] = acc[s];
    }
    __syncthreads();
}
__device__ __forceinline__ void mod_finalize(const Ctx& a, int gtid, int NGT) {
    const float* adab = a.in[I_ADAB];
    for (int e = gtid; e < 2 * NSLOT * 6144; e += NGT) { const int l = e / (NSLOT * 6144), r = e % (NSLOT * 6144), n = r % 6144;
        float s = adab[l * 6144 + n]; const float* pp = (const float*)(a.ws + WS_MODP) + (size_t)l * 8 * NSLOT * 6144 + r;
#pragma unroll
        for (int ks = 0; ks < 8; ++ks) s += pp[(size_t)ks * NSLOT * 6144];
        ((float*)(a.ws + WS_MOD))[e] = s; }
}

__device__ __forceinline__ void phase_norm(const Ctx& a, LAS unsigned char* lds, int l, int which, bool from_partials, bool x_from_inputs, int bid, int G, int tid, int wave, int lane) {
    LAS float* gs = (LAS float*)lds; LAS float* sh = gs + D;
    const float* gw = a.in[which ? I_NFFNG : I_NMIXG] + l * D; const float* adab = a.in[I_ADAB]; const float* xp = a.in[I_XP]; const float* xs = a.in[I_XS];
    bf16* H = (bf16*)(a.ws + WS_R1);
    for (int rb = bid; rb < MTOK / 64; rb += G) {
        const int r0 = rb * 64, slot = slot_of_row(r0);
        __syncthreads();
        for (int c = tid; c < D; c += NTHR) {
            float shv, scv;
            if (from_partials) {
                shv = adab[l * 6144 + (which * 3 + 0) * D + c]; scv = adab[l * 6144 + (which * 3 + 1) * D + c];
                const float* pp = (const float*)(a.ws + WS_MODP) + ((size_t)(l * 8) * NSLOT + slot) * 6144;
#pragma unroll
                for (int ks = 0; ks < 8; ++ks) { shv += pp[(size_t)ks * NSLOT * 6144 + (which * 3 + 0) * D + c]; scv += pp[(size_t)ks * NSLOT * 6144 + (which * 3 + 1) * D + c]; }
            } else {
                const float* mp = (const float*)(a.ws + WS_MOD) + ((size_t)l * NSLOT + slot) * 6144;
                shv = mp[(which * 3 + 0) * D + c]; scv = mp[(which * 3 + 1) * D + c];
            }
            gs[c] = gw[c] * (1.0f + scv); sh[c] = shv;
        }
        __syncthreads();
        for (int i = 0; i < 8; ++i) {
            const int r = r0 + wave * 8 + i;
            const float* xr = x_from_inputs ? (r < MCTX ? xp + (size_t)r * D : xs + (size_t)(r - MCTX) * D) : a.out + (size_t)r * D;
            f32x4 v[4]; float ss = 0.f;
#pragma unroll
            for (int q = 0; q < 4; ++q) { v[q] = *(const f32x4*)(xr + 4 * lane + 256 * q); ss += (v[q].x * v[q].x + v[q].y * v[q].y) + (v[q].z * v[q].z + v[q].w * v[q].w); }
            const float rinv = rsqrtf(wave_sum(ss) * (1.0f / D) + 1e-6f);
#pragma unroll
            for (int q = 0; q < 4; ++q) { const int c = 4 * lane + 256 * q; const f32x4 g4 = *(const LAS f32x4*)(gs + c), s4 = *(const LAS f32x4*)(sh + c);
                const f32x4 o = v[q] * rinv * g4 + s4; v2u w; w.x = cvt_pk_bf16(o.x, o.y); w.y = cvt_pk_bf16(o.z, o.w);
                *(v2u*)(H + (size_t)r * D + c) = w; }
        }
    }
    __syncthreads();
}
__device__ __forceinline__ void phase_final_norm(const Ctx& a, int gw, int NGW, int lane) {
    const float* g = a.in[I_FING];
    f32x4 g4[4];
#pragma unroll
    for (int q = 0; q < 4; ++q) g4[q] = *(const f32x4*)(g + 4 * lane + 256 * q);
    for (int r = gw; r < MTOK; r += NGW) {
        float* xr = a.out + (size_t)r * D; f32x4 v[4]; float ss = 0.f;
#pragma unroll
        for (int q = 0; q < 4; ++q) { v[q] = *(const f32x4*)(xr + 4 * lane + 256 * q); ss += (v[q].x * v[q].x + v[q].y * v[q].y) + (v[q].z * v[q].z + v[q].w * v[q].w); }
        const float rinv = rsqrtf(wave_sum(ss) * (1.0f / D) + 1e-6f);
#pragma unroll
        for (int q = 0; q < 4; ++q) *(f32x4*)(xr + 4 * lane + 256 * q) = v[q] * rinv * g4[q];
    }
}
__device__ __forceinline__ void phase_lru_conv(const Ctx& a, int l, int gtid, int NGT) {
    const bf16* P = (const bf16*)(a.ws + WS_P); bf16* U = (bf16*)(a.ws + WS_U);
    const float* cw = a.in[I_LCW] + l * 4 * 256; const float* cb = a.in[I_LCB] + l * 256;
    for (int it = gtid; it < MTOK * 32; it += NGT) {
        const int r = it >> 5, c0 = (it & 31) * 8;
        const int tt = r < MCTX ? (r & (T_CTX - 1)) : ((r - MCTX) & (T_LAT - 1)), Ts = r < MCTX ? T_CTX : T_LAT;
        float acc[8];
#pragma unroll
        for (int j = 0; j < 8; ++j) acc[j] = cb[c0 + j];
#pragma unroll
        for (int k = 0; k < 4; ++k) { const int t2 = tt + k - 2; if (t2 < 0 || t2 >= Ts) continue;
            const v4u x = *(const v4u*)(P + (size_t)(r + k - 2) * PP + C_XB + c0);
            const float xv[8] = {bf_lo(x.x), bf_hi(x.x), bf_lo(x.y), bf_hi(x.y), bf_lo(x.z), bf_hi(x.z), bf_lo(x.w), bf_hi(x.w)};
#pragma unroll
            for (int j = 0; j < 8; ++j) acc[j] += cw[k * 256 + c0 + j] * xv[j]; }
        v4u o; o.x = cvt_pk_bf16(acc[0], acc[1]); o.y = cvt_pk_bf16(acc[2], acc[3]); o.z = cvt_pk_bf16(acc[4], acc[5]); o.w = cvt_pk_bf16(acc[6], acc[7]);
        *(v4u*)(U + (size_t)r * 256 + c0) = o;
    }
}

constexpr int SCAN_BUF_BYTES = 49152;
constexpr int SCAN_OST_OFF = 2 * SCAN_BUF_BYTES, SCAN_OST_BYTES = 8192;
static_assert(SCAN_OST_OFF + 2 * SCAN_OST_BYTES <= RING_BYTES, "scan LDS");
template <int CTRL> __device__ __forceinline__ float dpp_add(float v) { return v + dpp_mov<CTRL>(v); }
__device__ __forceinline__ float fma_s(float a, float b, float c) { float d; asm("v_fma_f32 %0, %1, %2, %3" : "=v"(d) : "v"(a), "v"(b), "v"(c)); return d; }
__device__ __forceinline__ float fnma_s(float a, float b, float c) { float d; asm("v_fma_f32 %0, -%1, %2, %3" : "=v"(d) : "v"(a), "v"(b), "v"(c)); return d; }
__device__ __forceinline__ float mul_s(float a, float b) { float d; asm("v_mul_f32 %0, %1, %2" : "=v"(d) : "v"(a), "v"(b)); return d; }
__device__ __forceinline__ float add_s(float a, float b) { float d; asm("v_add_f32 %0, %1, %2" : "=v"(d) : "v"(a), "v"(b)); return d; }
__device__ __forceinline__ float rowsum8(float v) { v = dpp_add<0xB1>(v); v = dpp_add<0x4E>(v); v = dpp_add<0x141>(v); return v; }

struct SeqInfo { int row0, T, bl; bool latent; };
__device__ __forceinline__ SeqInfo seq_info(int b) { SeqInfo s; s.latent = b >= NB_CTX; s.bl = s.latent ? b - NB_CTX : b; s.row0 = s.latent ? MCTX + s.bl * T_LAT : b * T_CTX; s.T = s.latent ? T_LAT : T_CTX; return s; }
struct Combo { int b, h, d; };

template <int MIX  , int RV, int NW>
__device__ __forceinline__ void scan_unit(const Ctx& a, LAS unsigned char* lds, int l, Combo c0_, Combo c1_, int rh, int tid, int wave, int lane) {
    constexpr int NCOMBO = RV == 2 ? 2 : 1, TCX = 32 / NCOMBO, NARR = MIX == 0 ? 6 : 4, VA = NARR - 1;
    constexpr int ROWS_U = NW == 4 ? 32 : 64, VPT = ROWS_U / 16;
    constexpr int CFL = NARR * TCX * 64;
    static_assert(NCOMBO * CFL * 4 <= SCAN_BUF_BYTES && NCOMBO * TCX * 64 * 4 <= SCAN_OST_BYTES, "scan LDS carve");
    const bf16* P = (const bf16*)(a.ws + WS_P); const bf16* L = (const bf16*)(a.ws + WS_L);
    const int pslot = NCOMBO == 2 ? tid >> 8 : 0, tok = NCOMBO == 2 ? (tid >> 4) & 15 : tid >> 4, cq = tid & 15;
    const Combo pc = pslot ? c1_ : c0_;
    const SeqInfo psq = seq_info(pc.b);
    const int nch = psq.T / TCX, c0 = pc.h * 64 + 4 * cq;
    float pc0[4], pc1[4];
    { const float* t0 = MIX == 0 ? a.in[I_KK] : a.in[I_HLB]; const float* t1 = MIX == 0 ? a.in[I_KA] : t0;
#pragma unroll
    for (int j = 0; j < 4; ++j) {
        if (MIX == 0) { pc0[j] = t0[l * 512 + c0 + j]; pc1[j] = t1[l * 512 + c0 + j]; }
        else { float lb = 0.f; if (l == 1) lb = fsigmoid(t0[(pc.d * 2 + 1) * 256 + c0 + j] - t0[(pc.d * 2 + 0) * 256 + c0 + j]); pc0[j] = lb; pc1[j] = 1.0f - lb; }
    } }
    v2u raw[5];
    auto prep_load = [&](int c) {
        const int t0 = pc.d == 0 ? c * TCX : psq.T - (c + 1) * TCX; const size_t row = (size_t)(psq.row0 + t0 + tok);
        if (MIX == 0) {
            raw[0] = *(const v2u*)(P + row * PP + C_R + c0); raw[1] = *(const v2u*)(P + row * PP + C_K + c0); raw[2] = *(const v2u*)(P + row * PP + C_V + c0);
            raw[3] = *(const v2u*)(L + row * NLORA + pc.d * 512 + c0); raw[4] = *(const v2u*)(L + row * NLORA + 1024 + pc.d * 512 + c0);
        } else {
            raw[0] = *(const v2u*)(P + row * PP + C_Q + c0); raw[1] = *(const v2u*)(P + row * PP + C_FF + pc.d * 256 + c0); raw[2] = *(const v2u*)(P + row * PP + C_IV + c0);
        }
    };
    auto prep_store = [&](int bufi) {
        LAS float* buf = (LAS float*)(lds + bufi * SCAN_BUF_BYTES) + pslot * CFL + tok * 64 + 4 * cq;
        if (MIX == 0) {
            const f32x4 r4 = {bf_lo(raw[0].x), bf_hi(raw[0].x), bf_lo(raw[0].y), bf_hi(raw[0].y)};
            const f32x4 k4 = {bf_lo(raw[1].x), bf_hi(raw[1].x), bf_lo(raw[1].y), bf_hi(raw[1].y)};
            const f32x4 v4 = {bf_lo(raw[2].x), bf_hi(raw[2].x), bf_lo(raw[2].y), bf_hi(raw[2].y)};
            const f32x4 e4 = {bf_lo(raw[3].x), bf_hi(raw[3].x), bf_lo(raw[3].y), bf_hi(raw[3].y)};
            const f32x4 a4 = {bf_lo(raw[4].x), bf_hi(raw[4].x), bf_lo(raw[4].y), bf_hi(raw[4].y)};
            f32x4 kf, w4, b4, kd;
#pragma unroll
            for (int j = 0; j < 4; ++j) kf[j] = k4[j] * pc0[j];
            const float ss = rowsum16((kf[0] * kf[0] + kf[1] * kf[1]) + (kf[2] * kf[2] + kf[3] * kf[3]));
            const float rn = rsqrtf(ss + 1e-12f);
#pragma unroll
            for (int j = 0; j < 4; ++j) { kf[j] *= rn; w4[j] = __builtin_amdgcn_exp2f(-1.44269504089f * e4[j]); b4[j] = kf[j] * a4[j]; kd[j] = k4[j] * (1.0f + (a4[j] - 1.0f) * pc1[j]); }
            *(LAS f32x4*)(buf + 0 * TCX * 64) = kf; *(LAS f32x4*)(buf + 1 * TCX * 64) = w4; *(LAS f32x4*)(buf + 2 * TCX * 64) = b4;
            *(LAS f32x4*)(buf + 3 * TCX * 64) = kd; *(LAS f32x4*)(buf + 4 * TCX * 64) = r4; *(LAS f32x4*)(buf + 5 * TCX * 64) = v4;
        } else {
            const f32x4 q4 = {bf_lo(raw[0].x), bf_hi(raw[0].x), bf_lo(raw[0].y), bf_hi(raw[0].y)};
            const f32x4 g4 = {bf_lo(raw[1].x), bf_hi(raw[1].x), bf_lo(raw[1].y), bf_hi(raw[1].y)};
            const f32x4 v4 = {bf_lo(raw[2].x), bf_hi(raw[2].x), bf_lo(raw[2].y), bf_hi(raw[2].y)};
            f32x4 f4, kx, qs;
#pragma unroll
            for (int j = 0; j < 4; ++j) { f4[j] = pc0[j] + pc1[j] * fsigmoid(g4[j]); kx[j] = 1.0f - f4[j]; qs[j] = q4[j] * fsigmoid(q4[j]); }
            *(LAS f32x4*)(buf + 0 * TCX * 64) = f4; *(LAS f32x4*)(buf + 1 * TCX * 64) = kx; *(LAS f32x4*)(buf + 2 * TCX * 64) = qs; *(LAS f32x4*)(buf + 3 * TCX * 64) = v4;
        }
    };
    const bool scanner = wave < NW;
    const int sslot = NCOMBO == 2 ? wave >> 2 : 0, wcm = NCOMBO == 2 ? wave & 3 : wave;
    const Combo sc = sslot ? c1_ : c0_;
    const SeqInfo ssq = seq_info(sc.b);
    const int lv = lane >> 3, lk = lane & 7;
    const int grow = rh * 32 + wcm * 8 * RV + lv * RV;
    const int rloc = grow - rh * 32;
    f32x4 S[RV][2];
    if (scanner) {
        if (ssq.latent) {
            const float* stp = MIX == 0 ? a.in[I_SRWKV] : a.in[I_SHGRN];
#pragma unroll
            for (int j = 0; j < RV; ++j) {
                if (MIX == 0) { const float* st = stp + ((((size_t)ssq.bl * 2 + l) * 2 + sc.d) * 8 + sc.h) * 4096 + (size_t)(grow + j) * 64 + 8 * lk; S[j][0] = *(const f32x4*)st; S[j][1] = *(const f32x4*)(st + 4); }
                else { const float* st = stp + ((((size_t)ssq.bl * 2 + l) * 2 + sc.d) * 4 + sc.h) * 4096 + (grow + j);
                    S[j][0] = (f32x4){st[(8 * lk + 0) * 64], st[(8 * lk + 1) * 64], st[(8 * lk + 2) * 64], st[(8 * lk + 3) * 64]};
                    S[j][1] = (f32x4){st[(8 * lk + 4) * 64], st[(8 * lk + 5) * 64], st[(8 * lk + 6) * 64], st[(8 * lk + 7) * 64]}; }
            }
        } else {
#pragma unroll
            for (int j = 0; j < RV; ++j) { S[j][0] = (f32x4){0.f, 0.f, 0.f, 0.f}; S[j][1] = S[j][0]; }
        }
    }
    constexpr int OPITCH = MIX == 0 ? 512 : 256;
    auto write_out = [&](int c) {
        const int t0 = pc.d == 0 ? c * TCX : psq.T - (c + 1) * TCX;
        const LAS float* ost = (const LAS float*)(lds + SCAN_OST_OFF + (c & 1) * SCAN_OST_BYTES) + pslot * TCX * 64 + tok * 64 + cq * VPT;
        bf16* Od = (MIX == 0 ? (bf16*)(a.ws + WS_OR) : (bf16*)(a.ws + WS_OH)) + (size_t)pc.d * MTOK * OPITCH;
        bf16* op = Od + (size_t)(psq.row0 + t0 + tok) * OPITCH + pc.h * 64 + rh * 32 + cq * VPT;
        if (VPT == 2) { *(unsigned*)op = cvt_pk_bf16(ost[0], ost[1]); }
        else { v2u w; w.x = cvt_pk_bf16(ost[0], ost[1]); w.y = cvt_pk_bf16(ost[2], ost[3]); *(v2u*)op = w; }
    };
    struct Ops { f32x4 x[MIX == 0 ? 5 : 3][2]; float vv[RV]; };
    auto ld_ops = [&](Ops& o, const LAS float* buf, int i) {
        const LAS float* bp = buf + i * 64 + 8 * lk;
#pragma unroll
        for (int q = 0; q < (MIX == 0 ? 5 : 3); ++q) { o.x[q][0] = *(const LAS f32x4*)(bp + q * TCX * 64); o.x[q][1] = *(const LAS f32x4*)(bp + q * TCX * 64 + 4); }
#pragma unroll
        for (int j = 0; j < RV; ++j) o.vv[j] = buf[VA * TCX * 64 + i * 64 + grow + j];
    };
    float keep[RV];
    auto do_step = [&](const Ops& o, int s8) {
#pragma unroll
        for (int j = 0; j < RV; ++j) {
            f32x2 s[4] = {{S[j][0].x, S[j][0].y}, {S[j][0].z, S[j][0].w}, {S[j][1].x, S[j][1].y}, {S[j][1].z, S[j][1].w}};
#define OPK(q, p) ((f32x2){o.x[q][(p) >> 1][((p) & 1) * 2], o.x[q][(p) >> 1][((p) & 1) * 2 + 1]})
            float ov;
            if (MIX == 0) {
                f32x2 t = s[0] * OPK(0, 0); t = s[1] * OPK(0, 1) + t; t = s[2] * OPK(0, 2) + t; t = s[3] * OPK(0, 3) + t;
                f32x2 u[4];
#pragma unroll
                for (int p = 0; p < 4; ++p) u[p] = OPK(3, p) * o.vv[j];
                const float sa = rowsum8(t.x + t.y);
#pragma unroll
                for (int p = 0; p < 4; ++p) { s[p] = s[p] * OPK(1, p) + u[p]; s[p] = s[p] - OPK(2, p) * sa; }
                f32x2 q = s[0] * OPK(4, 0); q = s[1] * OPK(4, 1) + q; q = s[2] * OPK(4, 2) + q; q = s[3] * OPK(4, 3) + q;
                ov = rowsum8(q.x + q.y);
            } else {
#pragma unroll
                for (int p = 0; p < 4; ++p) s[p] = s[p] * OPK(0, p) + OPK(1, p) * o.vv[j];
                f32x2 q = s[0] * OPK(2, 0); q = s[1] * OPK(2, 1) + q; q = s[2] * OPK(2, 2) + q; q = s[3] * OPK(2, 3) + q;
                ov = rowsum8(q.x + q.y);
            }
#undef OPK
            S[j][0] = (f32x4){s[0].x, s[0].y, s[1].x, s[1].y}; S[j][1] = (f32x4){s[2].x, s[2].y, s[3].x, s[3].y};
            keep[j] = (lk == s8) ? ov : keep[j];
        }
    };
    __syncthreads();
    prep_load(0); prep_store(0);
    __syncthreads();
    for (int c = 0; c < nch; ++c) {
        if (c + 1 < nch) prep_load(c + 1);
        if (c > 0) write_out(c - 1);
        if (scanner) {
            const LAS float* buf = (const LAS float*)(lds + (c & 1) * SCAN_BUF_BYTES) + sslot * CFL;
            LAS float* ost = (LAS float*)(lds + SCAN_OST_OFF + (c & 1) * SCAN_OST_BYTES) + sslot * TCX * 64;
            const int i0 = sc.d == 0 ? 0 : TCX - 1, di = sc.d == 0 ? 1 : -1;
            Ops oa, ob;
            ld_ops(oa, buf, i0);
#pragma unroll 1
            for (int g = 0; g < TCX / 8; ++g) {
                const int ig = i0 + di * 8 * g;
#pragma unroll
                for (int j = 0; j < RV; ++j) keep[j] = 0.f;
#pragma unroll
                for (int s = 0; s < 8; s += 2) {
                    ld_ops(ob, buf, ig + di * (s + 1));
                    do_step(oa, s);
                    if (s + 2 < 8 || g + 1 < TCX / 8) ld_ops(oa, buf, ig + di * (s + 2));
                    do_step(ob, s + 1);
                }
#pragma unroll
                for (int j = 0; j < RV; ++j) ost[(ig + di * lk) * 64 + rloc + j] = keep[j];
            }
        }
        if (c + 1 < nch) prep_store((c + 1) & 1);
        __syncthreads();
    }
    write_out(nch - 1);
    if (scanner && !ssq.latent) {
#pragma unroll
        for (int j = 0; j < RV; ++j) {
            if (MIX == 0) { float* st = a.out + OUT_RWKV + ((((size_t)ssq.bl * 2 + l) * 2 + sc.d) * 8 + sc.h) * 4096 + (size_t)(grow + j) * 64 + 8 * lk; *(f32x4*)st = S[j][0]; *(f32x4*)(st + 4) = S[j][1]; }
            else { float* st = a.out + OUT_HGRN + ((((size_t)ssq.bl * 2 + l) * 2 + sc.d) * 4 + sc.h) * 4096 + (grow + j);
                st[(8 * lk + 0) * 64] = S[j][0].x; st[(8 * lk + 1) * 64] = S[j][0].y; st[(8 * lk + 2) * 64] = S[j][0].z; st[(8 * lk + 3) * 64] = S[j][0].w;
                st[(8 * lk + 4) * 64] = S[j][1].x; st[(8 * lk + 5) * 64] = S[j][1].y; st[(8 * lk + 6) * 64] = S[j][1].z; st[(8 * lk + 7) * 64] = S[j][1].w; }
        }
    }
}

__device__ __forceinline__ float gelu_tanh(float x) { return 0.5f * x * (1.0f + ftanh(0.7978845608f * (x + 0.044715f * x * x * x))); }
constexpr int LRU_SL = 32, LRU_MAXSL = T_LAT / LRU_SL;
struct LruTask { int b, cg, s; };
__device__ __forceinline__ size_t lru_ab_row(int b, int d, int s) { return b < NB_CTX ? (size_t)((b * 2 + d) * 8 + s) : (size_t)(512 + ((b - NB_CTX) * 2 + d) * 64 + s); }
__device__ __forceinline__ LruTask lru_task(int r) { LruTask t; if (r < 1024) { t.b = r >> 5; t.cg = (r >> 3) & 3; t.s = r & 7; } else { const int q = r - 1024; t.b = NB_CTX + (q >> 8); t.cg = (q >> 6) & 3; t.s = q & 63; } return t; }
__device__ __forceinline__ void lru_pass1(const Ctx& a, int tsk, int lane) {
    const int d = tsk & 1; const LruTask t = lru_task(tsk >> 1); const SeqInfo sq = seq_info(t.b);
    const bf16* G = (const bf16*)(a.ws + WS_G); f32x2* AB = (f32x2*)(a.ws + WS_U);
    const int ch = t.cg * 64 + lane;
    const bf16* gp = G + (size_t)(sq.row0 + t.s * LRU_SL) * 1024 + d * 512 + ch;
    bf16 la[LRU_SL], bb[LRU_SL];
#pragma unroll
    for (int i = 0; i < LRU_SL; ++i) { const int tt = d == 0 ? i : LRU_SL - 1 - i; la[i] = gp[(size_t)tt * 1024]; bb[i] = gp[(size_t)tt * 1024 + 256]; }
    float A = 1.f, B = 0.f;
#pragma unroll
    for (int i = 0; i < LRU_SL; ++i) { const float av = __builtin_amdgcn_exp2f(bf2f(la[i])); A *= av; B = av * B + bf2f(bb[i]); }
    AB[lru_ab_row(t.b, d, t.s) * 256 + ch] = (f32x2){A, B};
}
__device__ __forceinline__ float lru_fold(const f32x2* ABd, int ch, int first, int cnt, int step, float h) {
#pragma unroll 1
    for (int g = 0; g < cnt; g += 16) {
        f32x2 ab[16];
#pragma unroll
        for (int i = 0; i < 16; ++i) { ab[i] = (f32x2){1.f, 0.f}; if (g + i < cnt) ab[i] = ABd[(size_t)(first + step * (g + i)) * 256 + ch]; }
#pragma unroll
        for (int i = 0; i < 16; ++i) h = ab[i].x * h + ab[i].y;
    }
    return h;
}
__device__ __forceinline__ void lru_pass2(const Ctx& a, int l, int r, int lane) {
    const LruTask t = lru_task(r); const SeqInfo sq = seq_info(t.b);
    const bf16* G = (const bf16*)(a.ws + WS_G); const bf16* P = (const bf16*)(a.ws + WS_P); const f32x2* AB = (const f32x2*)(a.ws + WS_U); bf16* MIX = (bf16*)(a.ws + WS_R1);
    const int ch = t.cg * 64 + lane, nsl = sq.T / LRU_SL;
    const float* st = a.in[I_SLRU];
    const bf16* gp = G + (size_t)(sq.row0 + t.s * LRU_SL) * 1024 + ch;
    const bf16* pp = P + (size_t)(sq.row0 + t.s * LRU_SL) * PP + C_GB + ch;
    bf16 laf[LRU_SL], bbf[LRU_SL], lab[LRU_SL], bbb[LRU_SL], gb[LRU_SL];
#pragma unroll
    for (int i = 0; i < LRU_SL; ++i) { laf[i] = gp[(size_t)i * 1024]; bbf[i] = gp[(size_t)i * 1024 + 256]; lab[i] = gp[(size_t)i * 1024 + 512]; bbb[i] = gp[(size_t)i * 1024 + 768]; gb[i] = pp[(size_t)i * PP]; }
    float hf0 = sq.latent ? st[(((size_t)sq.bl * 2 + l) * 2 + 0) * 256 + ch] : 0.f, hb0 = sq.latent ? st[(((size_t)sq.bl * 2 + l) * 2 + 1) * 256 + ch] : 0.f;
    hf0 = lru_fold(AB + lru_ab_row(t.b, 0, 0) * 256, ch, 0, t.s, 1, hf0);
    hb0 = lru_fold(AB + lru_ab_row(t.b, 1, 0) * 256, ch, nsl - 1, nsl - 1 - t.s, -1, hb0);
    float hf[LRU_SL]; float h = hf0;
#pragma unroll
    for (int i = 0; i < LRU_SL; ++i) { h = __builtin_amdgcn_exp2f(bf2f(laf[i])) * h + bf2f(bbf[i]); hf[i] = h; }
    if (!sq.latent && t.s == nsl - 1) a.out[OUT_LRU + (((size_t)sq.bl * 2 + l) * 2 + 0) * 256 + ch] = h;
    bf16* mp = MIX + (size_t)(sq.row0 + t.s * LRU_SL) * D + 512 + ch;
    h = hb0;
#pragma unroll
    for (int i = LRU_SL - 1; i >= 0; --i) { h = __builtin_amdgcn_exp2f(bf2f(lab[i])) * h + bf2f(bbb[i]); mp[(size_t)i * D] = f2bf((hf[i] + h) * gelu_tanh(bf2f(gb[i]))); }
    if (!sq.latent && t.s == 0) a.out[OUT_LRU + (((size_t)sq.bl * 2 + l) * 2 + 1) * 256 + ch] = h;
}

constexpr int NU_RL = 64 * 2, NU_HL = 32 * 2, NU_RC = 256, NU_HC = 128, NU_L1 = 512, NU_ALL = NU_RL + NU_HL + NU_RC + NU_HC + NU_L1;
__device__ __forceinline__ Combo rwkv_combo(int i) { Combo c; c.d = i & 1; c.h = (i >> 1) & 7; c.b = i >> 4; return c; }
__device__ __forceinline__ Combo hgrn_combo(int i) { Combo c; c.d = i & 1; c.h = (i >> 1) & 3; c.b = i >> 3; return c; }
__device__ __forceinline__ void phase_scans(const Ctx& a, LAS unsigned char* lds, volatile LAS unsigned* MISC, int l, int rep, int tid, int wave, int lane) {
    unsigned* head = (unsigned*)(a.ws + WS_CTL) + CW_QUEUE + 64 * (l * 4 + rep);
    for (;;) {
        __syncthreads();
        if (tid == 0) MISC[0] = __hip_atomic_fetch_add(head, 1u, RLX_AGENT);
        __syncthreads();
        int u = (int)MISC[0];
        if (u >= NU_ALL) break;
        if (u < NU_RL) { const Combo c = rwkv_combo(512 + (u >> 1)); scan_unit<0, 1, 4>(a, lds, l, c, c, u & 1, tid, wave, lane); continue; } u -= NU_RL;
        if (u < NU_HL) { const Combo c = hgrn_combo(256 + (u >> 1)); scan_unit<1, 1, 4>(a, lds, l, c, c, u & 1, tid, wave, lane); continue; } u -= NU_HL;
        if (u < NU_RC) { scan_unit<0, 2, 8>(a, lds, l, rwkv_combo(2 * u), rwkv_combo(2 * u + 1), 0, tid, wave, lane); continue; } u -= NU_RC;
        if (u < NU_HC) { scan_unit<1, 2, 8>(a, lds, l, hgrn_combo(2 * u), hgrn_combo(2 * u + 1), 0, tid, wave, lane); continue; } u -= NU_HC;
        lru_pass1(a, u * 8 + wave, lane);
    }
}

__device__ __forceinline__ void phase_post(const Ctx& a, int l, int gw, int NGW, int lane) {
    const bf16* P = (const bf16*)(a.ws + WS_P); const bf16* L = (const bf16*)(a.ws + WS_L);
    const bf16* ORf = (const bf16*)(a.ws + WS_OR); const bf16* ORb = ORf + (size_t)MTOK * 512;
    const bf16* OHf = (const bf16*)(a.ws + WS_OH); const bf16* OHb = OHf + (size_t)MTOK * 256;
    bf16* MIX = (bf16*)(a.ws + WS_R1);
    for (int r = gw; r < 2048; r += NGW) lru_pass2(a, l, r, lane);
    const int sub = lane >> 4, li = lane & 15;
    const float* p_rk = a.in[I_RK] + l * 512; const float* p_lnw = a.in[I_LNW] + l * 512; const float* p_lnb = a.in[I_LNB] + l * 512; const float* p_hng = a.in[I_HNG] + l * 256;
    f32x4 rk[2], lw[2], lb[2];
#pragma unroll
    for (int pass = 0; pass < 2; ++pass) { const int c0 = (4 * pass + sub) * 64 + 4 * li; rk[pass] = *(const f32x4*)(p_rk + c0); lw[pass] = *(const f32x4*)(p_lnw + c0); lb[pass] = *(const f32x4*)(p_lnb + c0); }
    const f32x4 ng = *(const f32x4*)(p_hng + sub * 64 + 4 * li);
    for (int r = gw; r < MTOK; r += NGW) {
        const size_t row = (size_t)r;
        v2u of[2], ob[2], rr[2], kk[2], vv[2], gg[2];
#pragma unroll
        for (int pass = 0; pass < 2; ++pass) { const int c0 = (4 * pass + sub) * 64 + 4 * li;
            of[pass] = *(const v2u*)(ORf + row * 512 + c0); ob[pass] = *(const v2u*)(ORb + row * 512 + c0);
            rr[pass] = *(const v2u*)(P + row * PP + C_R + c0); kk[pass] = *(const v2u*)(P + row * PP + C_K + c0); vv[pass] = *(const v2u*)(P + row * PP + C_V + c0);
            gg[pass] = *(const v2u*)(L + row * NLORA + 2048 + c0); }
        const int ch0 = sub * 64 + 4 * li;
        const v2u hof = *(const v2u*)(OHf + row * 256 + ch0), hob = *(const v2u*)(OHb + row * 256 + ch0), hgg = *(const v2u*)(P + row * PP + C_OG + ch0);
#pragma unroll
        for (int pass = 0; pass < 2; ++pass) {
            const int c0 = (4 * pass + sub) * 64 + 4 * li;
            f32x4 o = {bf_lo(of[pass].x) + bf_lo(ob[pass].x), bf_hi(of[pass].x) + bf_hi(ob[pass].x), bf_lo(of[pass].y) + bf_lo(ob[pass].y), bf_hi(of[pass].y) + bf_hi(ob[pass].y)};
            const f32x4 r4 = {bf_lo(rr[pass].x), bf_hi(rr[pass].x), bf_lo(rr[pass].y), bf_hi(rr[pass].y)}, k4 = {bf_lo(kk[pass].x), bf_hi(kk[pass].x), bf_lo(kk[pass].y), bf_hi(kk[pass].y)};
            const f32x4 v4 = {bf_lo(vv[pass].x), bf_hi(vv[pass].x), bf_lo(vv[pass].y), bf_hi(vv[pass].y)}, g4 = {bf_lo(gg[pass].x), bf_hi(gg[pass].x), bf_lo(gg[pass].y), bf_hi(gg[pass].y)};
            const float mu = rowsum16((o.x + o.y) + (o.z + o.w)) * (1.0f / 64.0f);
            o = o - mu;
            const float var = rowsum16((o.x * o.x + o.y * o.y) + (o.z * o.z + o.w * o.w)) * (1.0f / 64.0f);
            const float rs = rsqrtf(var + 64e-5f);
            const float bon = rowsum16((r4.x * k4.x * rk[pass].x + r4.y * k4.y * rk[pass].y) + (r4.z * k4.z * rk[pass].z + r4.w * k4.w * rk[pass].w));
            const f32x4 y = (o * rs * lw[pass] + lb[pass] + v4 * bon) * g4;
            v2u w; w.x = cvt_pk_bf16(y.x, y.y); w.y = cvt_pk_bf16(y.z, y.w);
            *(v2u*)(MIX + row * D + c0) = w;
        }
        {
            const f32x4 o = {bf_lo(hof.x) + bf_lo(hob.x), bf_hi(hof.x) + bf_hi(hob.x), bf_lo(hof.y) + bf_lo(hob.y), bf_hi(hof.y) + bf_hi(hob.y)};
            const f32x4 g4 = {bf_lo(hgg.x), bf_hi(hgg.x), bf_lo(hgg.y), bf_hi(hgg.y)};
            const float ms = rowsum16((o.x * o.x + o.y * o.y) + (o.z * o.z + o.w * o.w)) * (1.0f / 64.0f);
            const float rs = rsqrtf(ms + 1e-6f);
            f32x4 y;
#pragma unroll
            for (int j = 0; j < 4; ++j) y[j] = o[j] * rs * ng[j] * (g4[j] * fsigmoid(g4[j]));
            v2u w; w.x = cvt_pk_bf16(y.x, y.y); w.y = cvt_pk_bf16(y.z, y.w);
            *(v2u*)(MIX + row * D + 768 + ch0) = w;
        }
    }
}
__device__ __forceinline__ void phase_ffn_act(const Ctx& a, int l, int gtid, int NGT) {
    const bf16* GU = (const bf16*)(a.ws + WS_GU); bf16* ACT = (bf16*)(a.ws + WS_ACT);
    const float* cw = a.in[I_FCW] + l * 3 * DFF; const float* cb = a.in[I_FCB] + l * DFF;
    for (int it = gtid; it < (MTOK / 4) * (DFF / 8); it += NGT) {
        const int r0 = (it / (DFF / 8)) * 4, c0 = (it % (DFF / 8)) * 8;
        const int tt = r0 < MCTX ? (r0 & 255) : (r0 & 63), Ts = r0 < MCTX ? 256 : 64;
        const int gc = (c0 >> 7) * 256 + (c0 & 127);
        v4u gx[6], ux[4];
#pragma unroll
        for (int k = 0; k < 6; ++k) { const int t2 = tt + k - 1; gx[k] = (v4u){0u, 0u, 0u, 0u}; if (t2 >= 0 && t2 < Ts) gx[k] = *(const v4u*)(GU + (size_t)(r0 + k - 1) * NGU + gc); }
#pragma unroll
        for (int k = 0; k < 4; ++k) ux[k] = *(const v4u*)(GU + (size_t)(r0 + k) * NGU + gc + 128);
        float w0[8], w1[8], w2[8], bs[8];
#pragma unroll
        for (int j = 0; j < 8; ++j) { w0[j] = cw[c0 + j]; w1[j] = cw[DFF + c0 + j]; w2[j] = cw[2 * DFF + c0 + j]; bs[j] = cb[c0 + j]; }
#pragma unroll
        for (int k = 0; k < 4; ++k) {
            const v4u xa = gx[k], xb = gx[k + 1], xc = gx[k + 2], up = ux[k];
            const float va[8] = {bf_lo(xa.x), bf_hi(xa.x), bf_lo(xa.y), bf_hi(xa.y), bf_lo(xa.z), bf_hi(xa.z), bf_lo(xa.w), bf_hi(xa.w)};
            const float vb[8] = {bf_lo(xb.x), bf_hi(xb.x), bf_lo(xb.y), bf_hi(xb.y), bf_lo(xb.z), bf_hi(xb.z), bf_lo(xb.w), bf_hi(xb.w)};
            const float vc[8] = {bf_lo(xc.x), bf_hi(xc.x), bf_lo(xc.y), bf_hi(xc.y), bf_lo(xc.z), bf_hi(xc.z), bf_lo(xc.w), bf_hi(xc.w)};
            const float uv[8] = {bf_lo(up.x), bf_hi(up.x), bf_lo(up.y), bf_hi(up.y), bf_lo(up.z), bf_hi(up.z), bf_lo(up.w), bf_hi(up.w)};
            float acc[8];
#pragma unroll
            for (int j = 0; j < 8; ++j) { const float g = bs[j] + w0[j] * va[j] + w1[j] * vb[j] + w2[j] * vc[j]; acc[j] = g * fsigmoid(g) * uv[j]; }
            v4u o; o.x = cvt_pk_bf16(acc[0], acc[1]); o.y = cvt_pk_bf16(acc[2], acc[3]); o.z = cvt_pk_bf16(acc[4], acc[5]); o.w = cvt_pk_bf16(acc[6], acc[7]);
            *(v4u*)(ACT + (size_t)(r0 + k) * DFF + c0) = o;
        }
    }
}

#ifndef REP_K
#define REP_K -2
#define REP_N 0
#endif
constexpr int PHL = 10, PHLX = PHL + REP_N, N_PHASES = 1 + 2 * PHLX + 1;
__global__ void __launch_bounds__(NTHR, 2) trunk_fwd(Args args) {
    extern __shared__ __attribute__((aligned(16))) unsigned char lds_raw[];
    LAS unsigned char* lds = (LAS unsigned char*)lds_raw;
    volatile LAS unsigned* MISC = (volatile LAS unsigned*)(lds + MISC_OFF);
    const int G = gridDim.x, bid = blockIdx.x, NGW = G * NWAVES, NGT = G * NTHR;
    { const int tid = threadIdx.x;
    for (int u = tid; u < (LDS_BYTES - LDSCTL_OFF) / 4; u += NTHR) ((LAS unsigned*)(lds + LDSCTL_OFF))[u] = 0u;
    __syncthreads();
    if (tid == 0) {
#pragma unroll
        for (int i = 0; i < 38; ++i) ((LAS unsigned long long*)(lds + PTBL_OFF))[i] = (unsigned long long)args.in[i];
        LAS unsigned long long* jd = (LAS unsigned long long*)(lds + JDESC_OFF);
        unsigned char* w = args.ws; float* o = args.out;
#pragma unroll
        for (int l = 0; l < 2; ++l) {
            const unsigned long long modl = (unsigned long long)(w + WS_MOD) + (unsigned long long)l * NSLOT * 6144 * 4;
#pragma unroll
            for (int k = 0; k < PHL; ++k) {
                LAS unsigned long long* d = jd + (1 + PHL * l + k) * 12;
                unsigned long long A = 0, Bt = 0, O = 0, f0 = 0, f1 = 0, f2 = 0, U = 0, xo = 0; unsigned N = 0, K = 0, lda = 0, kind = 0xffu, ldc = 0, rowperm = 0, kssh = 0, ksmsk = 0;
                if (k == 1) { A = (unsigned long long)(w + WS_R1); Bt = (unsigned long long)(w + WS_W + W_IN); N = NPROJ; K = D; lda = D; kind = pg8::K_PROJ; ldc = PP; O = (unsigned long long)(w + WS_P); }
                if (k == 2) { A = (unsigned long long)(w + WS_P) + C_LORA * 2; Bt = (unsigned long long)(w + WS_W + W_LORA); N = NLORA; K = KLORA; lda = PP; kssh = 2; ksmsk = 3; kind = pg8::K_LORA; ldc = NLORA; O = (unsigned long long)(w + WS_L);
                    f0 = (unsigned long long)(args.in[I_W0] + l * 1024); f1 = (unsigned long long)(args.in[I_A0] + l * 1024); }
                if (k == 3) { A = (unsigned long long)(w + WS_U); Bt = (unsigned long long)(w + WS_W + W_GATE); N = NGATE; K = KGATE; lda = 256; kssh = 0; ksmsk = 1; kind = pg8::K_GATES; ldc = 1024; O = (unsigned long long)(w + WS_G);
                    f0 = (unsigned long long)(args.in[I_LBA] + l * 512); f1 = (unsigned long long)(args.in[I_LBX] + l * 512); f2 = (unsigned long long)(w + WS_SP) + (unsigned long long)l * 512 * 4; U = (unsigned long long)(w + WS_U); }
                if (k == 6) { A = (unsigned long long)(w + WS_R1); Bt = (unsigned long long)(w + WS_W + W_OUT); N = D; K = D; lda = D; kind = pg8::K_RESID;
                    f0 = l == 0 ? (unsigned long long)args.in[I_XP] : (unsigned long long)o; f1 = l == 0 ? (unsigned long long)args.in[I_XS] : (unsigned long long)(o + (size_t)MCTX * D); f2 = modl + 2 * D * 4; xo = (unsigned long long)o; }
                if (k == 8) { A = (unsigned long long)(w + WS_R1); Bt = (unsigned long long)(w + WS_W + W_GU); N = NGU; K = D; lda = D; kind = pg8::K_GUACT; ldc = DFF; O = (unsigned long long)(w + WS_ACT); rowperm = 1;
                    f0 = (unsigned long long)(args.in[I_FCW] + l * 3 * DFF); f1 = (unsigned long long)(args.in[I_FCB] + l * DFF); }
                if (k == 9) { A = (unsigned long long)(w + WS_ACT); Bt = (unsigned long long)(w + WS_W + W_DOWN); N = D; K = DFF; lda = DFF; kind = pg8::K_RESID;
                    f0 = (unsigned long long)o; f1 = (unsigned long long)(o + (size_t)MCTX * D); f2 = modl + 5 * D * 4; xo = (unsigned long long)o; }
                d[0] = A; d[1] = Bt; d[2] = O; d[3] = f0; d[4] = f1; d[5] = f2; d[6] = U; d[7] = xo;
                d[8] = ((unsigned long long)K << 32) | N; d[9] = ((unsigned long long)kind << 32) | lda; d[10] = ((unsigned long long)rowperm << 32) | ldc; d[11] = ((unsigned long long)ksmsk << 32) | kssh;
            }
        }
        jd[9] = 0xffull << 32; jd[(1 + 2 * PHL) * 12 + 9] = 0xffull << 32;
    }
    __syncthreads(); }
    LAS unsigned long long* ptbl = (LAS unsigned long long*)(lds + PTBL_OFF);
    float* const out0 = args.out; unsigned char* const ws0 = args.ws;
    const int lo = args.ph_lo, hi = args.ph_hi;
    XcdBarrier bar; bar.bar = (unsigned*)(ws0 + WS_CTL) + CW_BAR; bar.x = 0; bar.st = nullptr;
    if (hi - lo > 1) bar = xcd_barrier_post((unsigned*)(ws0 + WS_CTL) + CW_BAR, MISC + 8);
#pragma unroll 1
    for (int ph = lo; ph < hi; ++ph) {
        int tid_ = threadIdx.x; asm volatile("" : "+v"(tid_));
        const int tid = tid_, lane = tid & 63, wave = __builtin_amdgcn_readfirstlane(tid >> 6), gw = bid * NWAVES + wave, gtid = bid * NTHR + tid;
        unsigned long long out_u = (unsigned long long)out0, ws_u = (unsigned long long)ws0; asm volatile("" : "+s"(out_u), "+s"(ws_u));
        float* out_ = (float*)(GAS float*)out_u; unsigned char* ws = (unsigned char*)(GAS unsigned char*)ws_u;
        const Ctx cx{{ptbl}, out_, ws};
        int l = 0, k = -1;
        int rep = 0;
        if (ph == N_PHASES - 1) k = 100; else if (ph > 0) { l = (ph - 1) / PHLX; k = (ph - 1) % PHLX;
            if (REP_N > 0 && k > REP_K) { if (k <= REP_K + REP_N) { rep = k - REP_K; k = REP_K; } else k -= REP_N; } }
        {
            const LAS unsigned long long* d = (const LAS unsigned long long*)(lds + JDESC_OFF) + (k == -1 ? 0 : (k == 100 ? 1 + 2 * PHL : 1 + PHL * l + k)) * 12;
            unsigned long long q[12];
#pragma unroll
            for (int i = 0; i < 12; ++i) { const unsigned long long v = d[i];
                q[i] = ((unsigned long long)__builtin_amdgcn_readfirstlane((unsigned)(v >> 32)) << 32) | (unsigned)__builtin_amdgcn_readfirstlane((unsigned)v); }
            const unsigned kind = (unsigned)(q[9] >> 32);
            if (kind != 0xffu) {
                pg8::Gemm g; pg8::EpiAny E;
                g.A = (const bf16*)(const GAS bf16*)q[0]; g.Bt = (const bf16*)(const GAS bf16*)q[1]; g.M = MTOK; g.N = (int)(unsigned)q[8]; g.K = (int)(q[8] >> 32); g.lda = (int)(unsigned)q[9]; g.rowperm = (int)(q[10] >> 32); g.ks_sh = (int)(unsigned)q[11]; g.ks_msk = (int)(q[11] >> 32);
                E.kind = (int)kind; E.ldc = (int)(unsigned)q[10]; E.O = (bf16*)(GAS bf16*)q[2]; E.f0 = (const float*)(const GAS float*)q[3]; E.f1 = (const float*)(const GAS float*)q[4];
                E.f2 = (const float*)(const GAS float*)q[5]; E.U = (const bf16*)(const GAS bf16*)q[6]; E.xout = (float*)(GAS float*)q[7];
                pg8::StaticOrder S; S.init(MTOK, g.N, G, bid);
                pg8::gemm_phase<pg8::EpiAny, pg8::StaticOrder, true, true>(lds + RING_OFF, g, S, E);
            }
        }
        if (k == -1) { mod_partials(cx, lds, bid, G, tid); convert_weights(cx, 0, lds, gw, NGW, wave, lane, gtid, NGT); }
        else if (k == 0) { if (l == 0) mod_finalize(cx, gtid, NGT); else convert_weights(cx, l, lds, gw, NGW, wave, lane, gtid, NGT);
            phase_norm(cx, lds, l, 0, l == 0, l == 0, bid, G, tid, wave, lane); }
        else if (k == 2) phase_lru_conv(cx, l, gtid, NGT);
        else if (k == 4) phase_scans(cx, lds, MISC, l, rep, tid, wave, lane);
        else if (k == 5) phase_post(cx, l, gw, NGW, lane);
        else if (k == 7) phase_norm(cx, lds, l, 1, false, false, bid, G, tid, wave, lane);
        else if (k == 100) phase_final_norm(cx, gw, NGW, lane);
        if (ph + 1 < hi) xcd_barrier(bar);
    }
}

#ifndef MK_PER_PHASE
#define MK_PER_PHASE 0
#endif
extern "C" void kernel_launch(void* const* d_in, const int* in_sizes, int n_in, void* d_out, int out_size, void* d_ws, size_t ws_size, hipStream_t stream) {
    static int grid = 0;
    if (grid == 0) {
        if (n_in != 38 || (size_t)out_size != OUT_END || ws_size < WS_END) { fprintf(stderr, "kernel_launch: unexpected shapes (n_in %d, out %d, ws %zu); nothing launched\n", n_in, out_size, ws_size); grid = -1; return; }
        int dev = 0, cus = 0, per_cu = 0;
        if (hipGetDevice(&dev) != hipSuccess || hipDeviceGetAttribute(&cus, hipDeviceAttributeMultiprocessorCount, dev) != hipSuccess) { grid = -1; return; }
        if (hipFuncSetAttribute((const void*)trunk_fwd, hipFuncAttributeMaxDynamicSharedMemorySize, LDS_BYTES) != hipSuccess) { fprintf(stderr, "kernel_launch: hipFuncSetAttribute failed\n"); grid = -1; return; }
        if (hipOccupancyMaxActiveBlocksPerMultiprocessor(&per_cu, (const void*)trunk_fwd, NTHR, LDS_BYTES) != hipSuccess || per_cu < 1) { fprintf(stderr, "kernel_launch: occupancy query says %d\n", per_cu); (void)hipGetLastError(); per_cu = 1; }
        grid = cus;
    }
    if (grid < 0) return;
    (void)hipMemsetAsync((char*)d_ws + WS_CTL, 0, CTL_ZERO_BYTES, stream);
    Args a{};
    for (int i = 0; i < 38; ++i) a.in[i] = (const float*)d_in[i];
    a.out = (float*)d_out; a.ws = (unsigned char*)d_ws;
#if MK_PER_PHASE
    for (int p = 0; p < N_PHASES; ++p) { a.ph_lo = p; a.ph_hi = p + 1; hipLaunchKernelGGL(trunk_fwd, dim3(grid), dim3(NTHR), LDS_BYTES, stream, a); }
#else
    a.ph_lo = 0; a.ph_hi = N_PHASES;
    hipLaunchKernelGGL(trunk_fwd, dim3(grid), dim3(NTHR), LDS_BYTES, stream, a);
#endif
}
```
